# Optimizing an MI355X kernel written in HIP

```python
import jax, jax.numpy as jnp
from jax import lax
import numpy as np

D_MODEL = 1024
BATCH = 16
SEQ = 4096
DEPTH = 2

GRID_W = 64
CTX_LEN = 256
MIX_WIDTH = D_MODEL
GLA_WIDTH = MIX_WIDTH // 2
GLA_HEADS = 4
GLA_DV = GLA_WIDTH // GLA_HEADS
GLA_DK = GLA_DV // 2
GLA_KDIM = GLA_HEADS * GLA_DK
GLA_GATE_RANK = 16
GLA_GATE_NORM = 16.0
GLA_CHUNK = 64
NA_WIDTH = MIX_WIDTH - GLA_WIDTH
NA_HEADS = 8
NA_DH = NA_WIDTH // NA_HEADS
NA_WIN_H = 8
NA_WIN_W = 16
ROPE_BASE = 10000.0
D_FF = 11 * D_MODEL // 4
N_EXPERTS = 8
TOP_K = 2
D_FF_EXPERT = 7 * D_MODEL // 2
N_DENSE = (DEPTH + 1) // 2
N_MOE = DEPTH // 2
EPS = 1e-6
PROJ_SIZES = (GLA_KDIM, GLA_KDIM, GLA_WIDTH, GLA_WIDTH, 2 * GLA_GATE_RANK, NA_WIDTH, NA_WIDTH, NA_WIDTH)
PROJ_TOTAL = 2 * GLA_KDIM + 2 * GLA_WIDTH + 2 * GLA_GATE_RANK + 3 * NA_WIDTH

kernel_name = "hybrid_gla_natten_moe_dit"


def rmsnorm(x, g):
    xf = x.astype(jnp.float32)
    y = xf * lax.rsqrt(jnp.mean(xf * xf, axis=-1, keepdims=True) + EPS)
    return (y * g.astype(jnp.float32)).astype(x.dtype)


def modulation(cond, w, b):
    return jnp.split(jax.nn.silu(cond) @ w + b, 6, axis=-1)


def rope_1d(x, pos):
    half = x.shape[-1] // 2
    inv = ROPE_BASE ** (-jnp.arange(half, dtype=jnp.float32) / half)
    ang = pos.astype(jnp.float32)[:, None] * inv[None, :]
    cos = jnp.cos(ang)[:, None, :].astype(x.dtype)
    sin = jnp.sin(ang)[:, None, :].astype(x.dtype)
    x1, x2 = x[..., :half], x[..., half:]
    return jnp.concatenate([x1 * cos - x2 * sin, x1 * sin + x2 * cos], axis=-1)


def rope_2d(x, row, col):
    h = x.shape[-1] // 2
    return jnp.concatenate([rope_1d(x[..., :h], row), rope_1d(x[..., h:], col)], axis=-1)


def split_proj(p):
    return jnp.split(p, np.cumsum(PROJ_SIZES)[:-1].tolist(), axis=-1)


def gla_chunk(q, k, v, g, s0):
    B, H, L, dk = q.shape
    dv = v.shape[-1]
    C = GLA_CHUNK
    n = L // C
    q = q.reshape(B, H, n, C, dk)
    k = k.reshape(B, H, n, C, dk)
    v = v.reshape(B, H, n, C, dv)
    b = jnp.cumsum(g.reshape(B, H, n, C, dk), axis=3)
    b_ref = b[:, :, :, C // 2:C // 2 + 1, :]
    a = jnp.einsum('bhncd,bhnsd->bhncs', q * jnp.exp(b - b_ref), k * jnp.exp(b_ref - b))
    lower = jnp.tril(jnp.ones((C, C), dtype=bool))
    a = jnp.where(lower, a, 0.0)
    o = jnp.einsum('bhncs,bhnsv->bhncv', a, v)
    b_last = b[:, :, :, -1:, :]
    ds = jnp.einsum('bhnsd,bhnsv->bhndv', k * jnp.exp(b_last - b), v)
    decay = jnp.exp(b_last[:, :, :, 0, :])

    def step(s, inp):
        dec, d = inp
        return dec[..., None] * s + d, s

    s_fin, s_prev = lax.scan(step, s0, (jnp.moveaxis(decay, 2, 0), jnp.moveaxis(ds, 2, 0)))
    o = o + jnp.einsum('bhncd,nbhdv->bhncv', q * jnp.exp(b), s_prev)
    return o.reshape(B, H, L, dv), s_fin


def flip_seq(t):
    return jnp.flip(t, axis=2)


def bidir_gla(q, k, v, g_fwd, g_bwd, s_fwd0, s_bwd0):
    o_f, s_f = gla_chunk(q, k, v, g_fwd, s_fwd0)
    o_b, s_b = gla_chunk(flip_seq(q), flip_seq(k), flip_seq(v), flip_seq(g_bwd), s_bwd0)
    return o_f + flip_seq(o_b), s_f, s_b


def gla_inputs(q, k, v, lr, w_gate, b_gate, row, col):
    B, L, _ = q.shape
    q = q.reshape(B, L, GLA_HEADS, GLA_DK)
    k = k.reshape(B, L, GLA_HEADS, GLA_DK)
    if row is not None:
        q = rope_2d(q, row, col)
        k = rope_2d(k, row, col)
    q = q * GLA_DK ** -0.5
    v = v.reshape(B, L, GLA_HEADS, GLA_DV)
    lr_f, lr_b = jnp.split(lr, 2, axis=-1)

    def gate(z, w, bias):
        logit = (z @ w + bias).astype(jnp.float32)
        return (jax.nn.log_sigmoid(logit) / GLA_GATE_NORM).reshape(B, L, GLA_HEADS, GLA_DK)

    g_f = gate(lr_f, w_gate[0], b_gate[0])
    g_b = gate(lr_b, w_gate[1], b_gate[1])
    to_bhl = lambda t: jnp.swapaxes(t, 1, 2).astype(jnp.float32)
    return to_bhl(q), to_bhl(k), to_bhl(v), to_bhl(g_f), to_bhl(g_b)


def gla_output(o, r, gain):
    B, H, L, dv = o.shape
    o = rmsnorm(jnp.swapaxes(o, 1, 2), gain).reshape(B, L, H * dv).astype(r.dtype)
    return o * jax.nn.silu(r)


def neighbourhood_attention(q, k, v, kc, vc, rpb):
    B, L, H, dh = q.shape
    rows = L // GRID_W
    kh = min(NA_WIN_H, rows)
    cols = np.arange(GRID_W)
    cidx = np.clip(cols - NA_WIN_W // 2, 0, GRID_W - NA_WIN_W)[:, None] + np.arange(NA_WIN_W)[None, :]
    coff = cidx - cols[:, None] + NA_WIN_W - 1
    kg = k.reshape(B, rows, GRID_W, H, dh)
    vg = v.reshape(B, rows, GRID_W, H, dh)
    qg = jnp.moveaxis(q.reshape(B, rows, GRID_W, H, dh), 1, 0) * dh ** -0.5
    n_loc = kh * NA_WIN_W

    def row_block(args):
        q_r, r = args
        rs = jnp.clip(r - kh // 2, 0, rows - kh)
        kb = lax.dynamic_slice_in_dim(kg, rs, kh, axis=1)[:, :, cidx]
        vb = lax.dynamic_slice_in_dim(vg, rs, kh, axis=1)[:, :, cidx]
        roff = rs + jnp.arange(kh) - r + NA_WIN_H - 1
        bias = jnp.transpose(rpb[:, roff[:, None, None], coff[None]], (0, 2, 1, 3))
        s_loc = jnp.einsum('bqhd,biqjhd->bhqij', q_r, kb) + bias
        s_ctx = jnp.einsum('bqhd,bchd->bhqc', q_r, kc)
        s = jnp.concatenate([s_loc.reshape(B, H, GRID_W, n_loc), s_ctx], axis=-1).astype(jnp.float32)
        p = jax.nn.softmax(s, axis=-1).astype(v.dtype)
        p_loc = p[..., :n_loc].reshape(B, H, GRID_W, kh, NA_WIN_W)
        return (jnp.einsum('bhqij,biqjhd->bqhd', p_loc, vb)
                + jnp.einsum('bhqc,bchd->bqhd', p[..., n_loc:], vc))

    out = lax.map(row_block, (qg, jnp.arange(rows)))
    return jnp.moveaxis(out, 0, 1).reshape(B, L, H * dh)


def context_attention(q, k, v):
    B, Lc, H, dh = q.shape
    s = jnp.einsum('bqhd,bkhd->bhqk', q, k).astype(jnp.float32) * dh ** -0.5
    p = jax.nn.softmax(s, axis=-1).astype(v.dtype)
    return jnp.einsum('bhqk,bkhd->bqhd', p, v).reshape(B, Lc, H * dh)


def mixer(h, hc, w_in, w_out, gla_w_gate, gla_b_gate, gla_g_norm, na_rpb, with_ctx_out):
    B, L, _ = h.shape
    pos = jnp.arange(L)
    row, col = pos // GRID_W, pos % GRID_W
    gq, gk, gv, gr, glr, nq, nk, nv = split_proj(h @ w_in)
    cq, ck, cv, cr, clr, cnq, cnk, cnv = split_proj(hc @ w_in)
    s0 = jnp.zeros((B, GLA_HEADS, GLA_DK, GLA_DV), jnp.float32)
    oc, s_fwd, s_bwd = bidir_gla(*gla_inputs(cq, ck, cv, clr, gla_w_gate, gla_b_gate, None, None), s0, s0)
    ol, _, _ = bidir_gla(*gla_inputs(gq, gk, gv, glr, gla_w_gate, gla_b_gate, row, col), s_fwd, s_bwd)
    heads = lambda t: t.reshape(t.shape[0], t.shape[1], NA_HEADS, NA_DH)
    na_lat = neighbourhood_attention(heads(nq), heads(nk), heads(nv), heads(cnk), heads(cnv), na_rpb)
    y = jnp.concatenate([gla_output(ol, gr, gla_g_norm), na_lat], axis=-1) @ w_out
    if not with_ctx_out:
        return y, None
    na_ctx = context_attention(heads(cnq), heads(cnk), heads(cnv))
    yc = jnp.concatenate([gla_output(oc, cr, gla_g_norm), na_ctx], axis=-1) @ w_out
    return y, yc


def swiglu(h, wg, wu, wd):
    return (jax.nn.silu(h @ wg) * (h @ wu)) @ wd


def moe_swiglu(h, w_router, wg, wu, wd):
    def per_sample(t):
        logits = (t @ w_router).astype(jnp.float32)
        top_v, top_i = lax.top_k(logits, TOP_K)
        wts = jax.nn.softmax(top_v, axis=-1)
        combine = jnp.einsum('tk,tke->te', wts, jax.nn.one_hot(top_i, N_EXPERTS, dtype=jnp.float32)).astype(t.dtype)
        hid = jax.nn.silu(jnp.einsum('td,edf->tef', t, wg)) * jnp.einsum('td,edf->tef', t, wu)
        return jnp.einsum('tef,efd->td', hid * combine[:, :, None], wd)
    return lax.map(per_sample, h)


def setup_inputs(seed: int = 0) -> dict:
    key = jax.random.key(seed)
    ks = jax.random.split(key, 24)
    nrm = lambda k, shape, scale: jax.random.normal(k, shape, jnp.float32) * scale
    D = D_MODEL
    return {
        "x": nrm(ks[0], (BATCH, SEQ, D), 1.0),
        "c": nrm(ks[1], (BATCH, D), 1.0),
        "ctx": nrm(ks[2], (BATCH, CTX_LEN, D), 1.0),
        "c_ctx": nrm(ks[3], (D,), 1.0),
        "w_ada": nrm(ks[4], (DEPTH, D, 6 * D), 0.5 * D ** -0.5),
        "b_ada": nrm(ks[5], (DEPTH, 6 * D), 0.02),
        "g_pre_mix": 1.0 + nrm(ks[6], (DEPTH, D), 0.02),
        "g_post_mix": 1.0 + nrm(ks[7], (DEPTH, D), 0.02),
        "g_pre_ffn": 1.0 + nrm(ks[8], (DEPTH, D), 0.02),
        "g_post_ffn": 1.0 + nrm(ks[9], (DEPTH, D), 0.02),
        "w_in": nrm(ks[10], (DEPTH, D, PROJ_TOTAL), D ** -0.5),
        "gla_w_gate": nrm(ks[11], (DEPTH, 2, GLA_GATE_RANK, GLA_KDIM), GLA_GATE_RANK ** -0.5),
        "gla_b_gate": nrm(ks[12], (DEPTH, 2, GLA_KDIM), 0.1),
        "gla_g_norm": 1.0 + nrm(ks[13], (DEPTH, GLA_DV), 0.02),
        "na_rpb": nrm(ks[14], (DEPTH, NA_HEADS, 2 * NA_WIN_H - 1, 2 * NA_WIN_W - 1), 0.1),
        "w_out": nrm(ks[15], (DEPTH, MIX_WIDTH, D), MIX_WIDTH ** -0.5),
        "ffn_w_gate": nrm(ks[16], (N_DENSE, D, D_FF), D ** -0.5),
        "ffn_w_up": nrm(ks[17], (N_DENSE, D, D_FF), D ** -0.5),
        "ffn_w_down": nrm(ks[18], (N_DENSE, D_FF, D), D_FF ** -0.5),
        "moe_w_router": nrm(ks[19], (N_MOE, D, N_EXPERTS), D ** -0.5),
        "moe_w_gate": nrm(ks[20], (N_MOE, N_EXPERTS, D, D_FF_EXPERT), D ** -0.5),
        "moe_w_up": nrm(ks[21], (N_MOE, N_EXPERTS, D, D_FF_EXPERT), D ** -0.5),
        "moe_w_down": nrm(ks[22], (N_MOE, N_EXPERTS, D_FF_EXPERT, D), D_FF_EXPERT ** -0.5),
    }


def reference(x, c, ctx, c_ctx, w_ada, b_ada, g_pre_mix, g_post_mix, g_pre_ffn, g_post_ffn, w_in,
              gla_w_gate, gla_b_gate, gla_g_norm, na_rpb, w_out, ffn_w_gate, ffn_w_up, ffn_w_down,
              moe_w_router, moe_w_gate, moe_w_up, moe_w_down):
    def channel_mixer(i, h):
        j = i // 2
        if i % 2 == 0:
            return swiglu(h, ffn_w_gate[j], ffn_w_up[j], ffn_w_down[j])
        return moe_swiglu(h, moe_w_router[j], moe_w_gate[j], moe_w_up[j], moe_w_down[j])

    for i in range(DEPTH):
        last = i == DEPTH - 1
        sh1, sc1, gt1, sh2, sc2, gt2 = [m[:, None, :] for m in modulation(c, w_ada[i], b_ada[i])]
        csh1, csc1, cgt1, csh2, csc2, cgt2 = modulation(c_ctx, w_ada[i], b_ada[i])
        h = rmsnorm(x, g_pre_mix[i]) * (1.0 + sc1) + sh1
        hc = rmsnorm(ctx, g_pre_mix[i]) * (1.0 + csc1) + csh1
        y, yc = mixer(h, hc, w_in[i], w_out[i], gla_w_gate[i], gla_b_gate[i], gla_g_norm[i], na_rpb[i], not last)
        x = x + gt1 * rmsnorm(y, g_post_mix[i])
        h = rmsnorm(x, g_pre_ffn[i]) * (1.0 + sc2) + sh2
        x = x + gt2 * rmsnorm(channel_mixer(i, h), g_post_ffn[i])
        if not last:
            ctx = ctx + cgt1 * rmsnorm(yc, g_post_mix[i])
            hc = rmsnorm(ctx, g_pre_ffn[i]) * (1.0 + csc2) + csh2
            ctx = ctx + cgt2 * rmsnorm(channel_mixer(i, hc), g_post_ffn[i])
    return x
```

```cpp
#include <hip/hip_runtime.h>
#include <cstdio>
#include <cstdint>

namespace pg8 {
#define PG8_LAS __attribute__((address_space(3)))
typedef unsigned short bf16_t;
typedef short bf16x8 __attribute__((ext_vector_type(8)));
typedef float f32x4 __attribute__((ext_vector_type(4)));
typedef unsigned u32x4 __attribute__((ext_vector_type(4)));
typedef unsigned u32x2 __attribute__((ext_vector_type(2)));
constexpr int BM = 256, BK = 64, HALF = 128, HTB = HALF * BK * 2, STAGE_BYTES = 8 * HTB, NXCD = 8, WGM = 8;

__host__ __device__ __forceinline__ int lds_byte(int r, int c) { const int st = (r >> 4) * 2 + (c >> 5), rr = r & 15, cc = c & 31, ob = rr * 64 + cc * 2; return st * 1024 + (ob ^ (((ob >> 9) & 1) << 5)); }
__host__ __device__ __forceinline__ void stage_rc(int b, int& R, int& C) { const int st = b / 1024, sb = b % 1024, swz = sb ^ (((sb >> 9) & 1) << 5); R = (st >> 1) * 16 + swz / 64; C = (st & 1) * 32 + (swz % 64) / 2; }
__host__ __device__ __forceinline__ int perm32(int rho) { const int n = rho >> 4, i = rho & 15; return 8 * (i >> 2) + 4 * n + (i & 3); }

struct Unit { int pm, pn; };
struct Gemm { const bf16_t* A; const bf16_t* Bt; int M, N, K; const PG8_LAS int* texp; size_t estride; };

struct StaticOrder {
    int nM, nN, nwg, G, c;
    __host__ __device__ void init(int M, int N, int G_, int c_) { nM = M / BM; nN = N / BM; nwg = nM * nN; G = G_; c = c_; }
    __host__ __device__ bool next(int i, Unit& u) const {
        const long L = (long)i * G + c; if (L >= nwg) return false;
        int wgid = (int)L; { const int q = nwg / NXCD, r = nwg % NXCD, xcd = wgid % NXCD, off = wgid / NXCD; wgid = (xcd < r ? xcd * (q + 1) : r * (q + 1) + (xcd - r) * q) + off; }
        const int nig = WGM * nN, gid = wgid / nig, fm = gid * WGM, gsz = (nM - fm) < WGM ? (nM - fm) : WGM;
        u.pm = fm + ((wgid % nig) % gsz); u.pn = (wgid % nig) / gsz; return true;
    }
};

__device__ __forceinline__ unsigned cvt_pk_bf16(float lo, float hi) { unsigned r; asm volatile("v_cvt_pk_bf16_f32 %0, %1, %2" : "=v"(r) : "v"(lo), "v"(hi)); return r; }

struct EpiBf16 {
    static constexpr bool PERM = true;
    bf16_t* O; int ldc;
    __device__ __forceinline__ void operator()(const f32x4 (&acc)[2][2][4][2], const Unit& u, int wr, int wc, int fr, int fq) const {
        const int row0 = u.pm * BM + wr * 64 + fr; const int col0 = u.pn * BM + wc * 32 + 8 * fq;
#pragma unroll
        for (int ai = 0; ai < 2; ++ai)
#pragma unroll
            for (int m = 0; m < 4; ++m) { bf16_t* rowp = O + (size_t)(row0 + ai * HALF + m * 16) * ldc + col0;
#pragma unroll
                for (int bj = 0; bj < 2; ++bj) { const f32x4 v0 = acc[ai][bj][m][0], v1 = acc[ai][bj][m][1];
                    u32x4 w; w.x = cvt_pk_bf16(v0[0], v0[1]); w.y = cvt_pk_bf16(v0[2], v0[3]); w.z = cvt_pk_bf16(v1[0], v1[1]); w.w = cvt_pk_bf16(v1[2], v1[3]);
                    *(u32x4*)(rowp + bj * HALF) = w; } }
    }
};
__device__ __forceinline__ float silu_f(float g) { return g * __builtin_amdgcn_rcpf(1.0f + __builtin_amdgcn_exp2f(-1.44269504f * g)); }

typedef int i32x4 __attribute__((ext_vector_type(4)));
template <int MODE> struct AccT { typedef f32x4 type; };
template <> struct AccT<1> { typedef i32x4 type; };
template <int MODE> __device__ __forceinline__ typename AccT<MODE>::type mma_pair(const bf16x8 (&b)[2], const bf16x8 (&a)[2], typename AccT<MODE>::type c) {
    if constexpr (MODE == 1) { c = __builtin_amdgcn_mfma_i32_16x16x64_i8(__builtin_bit_cast(i32x4, b[0]), __builtin_bit_cast(i32x4, a[0]), c, 0, 0, 0);
        return __builtin_amdgcn_mfma_i32_16x16x64_i8(__builtin_bit_cast(i32x4, b[1]), __builtin_bit_cast(i32x4, a[1]), c, 0, 0, 0); }
    else { c = __builtin_amdgcn_mfma_f32_16x16x32_bf16(b[0], a[0], c, 0, 0, 0); return __builtin_amdgcn_mfma_f32_16x16x32_bf16(b[1], a[1], c, 0, 0, 0); }
}
struct EpiBf16Q {
    static constexpr bool PERM = true;
    bf16_t* O; int ldc; const float* sa; const float* sb; const PG8_LAS int* texp; int sbstride; float sconst;
    __device__ __forceinline__ void operator()(const i32x4 (&acc)[2][2][4][2], const Unit& u, int wr, int wc, int fr, int fq) const {
        const int row0 = u.pm * BM + wr * 64 + fr; const int col0 = u.pn * BM + wc * 32 + 8 * fq;
        const float* sbe = sb + (texp ? (size_t)__builtin_amdgcn_readfirstlane(texp[u.pm]) * sbstride : (size_t)0);
        f32x4 cb[2][2];
#pragma unroll
        for (int bj = 0; bj < 2; ++bj) { cb[bj][0] = *(const f32x4*)(sbe + col0 + bj * HALF); cb[bj][1] = *(const f32x4*)(sbe + col0 + bj * HALF + 4); }
#pragma unroll
        for (int ai = 0; ai < 2; ++ai)
#pragma unroll
            for (int m = 0; m < 4; ++m) { const int row = row0 + ai * HALF + m * 16; const float ra = sa ? sa[row] : sconst; bf16_t* rowp = O + (size_t)row * ldc + col0;
#pragma unroll
                for (int bj = 0; bj < 2; ++bj) { const i32x4 a0 = acc[ai][bj][m][0], a1 = acc[ai][bj][m][1];
                    const f32x4 v0 = (f32x4){(float)a0[0], (float)a0[1], (float)a0[2], (float)a0[3]} * cb[bj][0] * ra, v1 = (f32x4){(float)a1[0], (float)a1[1], (float)a1[2], (float)a1[3]} * cb[bj][1] * ra;
                    u32x4 w; w.x = cvt_pk_bf16(v0[0], v0[1]); w.y = cvt_pk_bf16(v0[2], v0[3]); w.z = cvt_pk_bf16(v1[0], v1[1]); w.w = cvt_pk_bf16(v1[2], v1[3]);
                    *(u32x4*)(rowp + bj * HALF) = w; } }
    }
};
struct EpiSwiGLUQ8 {
    static constexpr bool PERM = false;
    signed char* Hd8; int ldh; const float* sa; const float* sb; const PG8_LAS int* texp; int sbstride; float hinv;
    __device__ __forceinline__ void operator()(const i32x4 (&acc)[2][2][4][2], const Unit& u, int wr, int wc, int fr, int fq) const {
        const int row0 = u.pm * BM + wr * 64 + fr;
        const float* sbe = sb + (texp ? (size_t)__builtin_amdgcn_readfirstlane(texp[u.pm]) * sbstride : (size_t)0) + u.pn * BM + wc * 32 + 4 * fq;
        f32x4 cg[2], cu[2];
#pragma unroll
        for (int bj = 0; bj < 2; ++bj) { cg[bj] = *(const f32x4*)(sbe + bj * HALF); cu[bj] = *(const f32x4*)(sbe + bj * HALF + 16); }
#pragma unroll
        for (int ai = 0; ai < 2; ++ai)
#pragma unroll
            for (int m = 0; m < 4; ++m) { const int row = row0 + ai * HALF + m * 16; const float ra = sa[row]; signed char* rowp = Hd8 + (size_t)row * ldh;
#pragma unroll
                for (int bj = 0; bj < 2; ++bj) { const i32x4 gi = acc[ai][bj][m][0], ui = acc[ai][bj][m][1];
                    const f32x4 g = (f32x4){(float)gi[0], (float)gi[1], (float)gi[2], (float)gi[3]} * cg[bj] * ra, up = (f32x4){(float)ui[0], (float)ui[1], (float)ui[2], (float)ui[3]} * cu[bj] * (ra * hinv);
                    const int hc = 16 * (8 * u.pn + 4 * bj + wc) + 4 * fq;
                    unsigned w = 0u;
#pragma unroll
                    for (int e = 0; e < 4; ++e) { const float q = fminf(fmaxf(__builtin_rintf(silu_f(g[e]) * up[e]), -127.0f), 127.0f); w |= ((unsigned)(int)q & 255u) << (8 * e); }
                    *(unsigned*)(rowp + hc) = w; } }
    }
};

template <class Epi, class Sched, bool ALIGN_EPI, bool EXPERT, int MODE = 0  >
__device__ __forceinline__ void gemm_phase(PG8_LAS unsigned char* lds, const Gemm g, const Sched& S, const Epi& E) {
    const int tid = threadIdx.x, wid = __builtin_amdgcn_readfirstlane(tid >> 6), lane = tid & 63, wr = wid >> 2, wc = wid & 3, fr = lane & 15, fq = lane >> 4;
    const int K = g.K, nt = K / BK;
    unsigned voffA[2], voffB[2];
#pragma unroll
    for (int i = 0; i < 2; ++i) { int R, C; stage_rc(tid * 16 + i * 8192, R, C); const int Rb = Epi::PERM ? ((R & ~31) + perm32(R & 31)) : R;
        voffA[i] = (unsigned)(R * K + C) * 2u; voffB[i] = (unsigned)(Rb * K + C) * 2u; }
    const size_t kstep = (size_t)(BK * 2);
    const size_t hstep = (size_t)HALF * K * 2;
    const size_t tstep = 2 * hstep;
    const unsigned ldsw = (unsigned)wid * 1024u;
    const int aoff = lds_byte(wr * 64 + fr, fq * 8), boff = lds_byte(wc * 32 + fr, fq * 8);
#define PG8_SA(b, h) (((b) * 2 + (h)) * HTB)
#define PG8_SB(b, h) ((4 + (b) * 2 + (h)) * HTB)
#define PG8_STAGE(bufoff, gbase, voff) do { _Pragma("unroll") for (int _i = 0; _i < 2; ++_i) \
        __builtin_amdgcn_global_load_lds((const unsigned*)((const char*)(gbase) + (voff)[_i]), (PG8_LAS unsigned*)(lds + (bufoff) + ldsw + _i * 8192), 16, 0, 0); } while (0)
#define PG8_LDA(dst, b, h) do { _Pragma("unroll") for (int m = 0; m < 4; ++m) _Pragma("unroll") for (int k = 0; k < 2; ++k) dst[m][k] = *(const PG8_LAS bf16x8*)(lds + PG8_SA(b, h) + aoff + m * 2048 + k * 1024); } while (0)
#define PG8_LDB(dst, b, h) do { _Pragma("unroll") for (int n = 0; n < 2; ++n) _Pragma("unroll") for (int k = 0; k < 2; ++k) dst[n][k] = *(const PG8_LAS bf16x8*)(lds + PG8_SB(b, h) + boff + n * 2048 + k * 1024); } while (0)
#define PG8_MMA(ai, bj, At, Bt) do { __builtin_amdgcn_s_setprio(1); _Pragma("unroll") for (int m = 0; m < 4; ++m) _Pragma("unroll") for (int n = 0; n < 2; ++n) \
        acc[ai][bj][m][n] = mma_pair<MODE>(Bt[n], At[m], acc[ai][bj][m][n]); __builtin_amdgcn_s_setprio(0); } while (0)
#define PG8_WAIT_V(n) asm volatile("s_waitcnt vmcnt(" #n ")" ::: "memory")
#define PG8_WAIT_L(n) asm volatile("s_waitcnt lgkmcnt(" #n ")" ::: "memory")
#define PG8_BAR __builtin_amdgcn_s_barrier()
#define PG8_SCHED __builtin_amdgcn_sched_barrier(0)
#define PG8_BPTR(u) ((const char*)g.Bt + (EXPERT ? (size_t)__builtin_amdgcn_readfirstlane(g.texp[(u).pm]) * g.estride * 2 : (size_t)0) + (size_t)(u).pn * tstep)
    Unit cur, nxt; int ui = 0;
    if (!S.next(0, cur)) return;
    typedef typename AccT<MODE>::type acc_t;
    acc_t acc[2][2][4][2];
#pragma unroll
    for (int a = 0; a < 2; ++a)
#pragma unroll
        for (int b = 0; b < 2; ++b)
#pragma unroll
            for (int m = 0; m < 4; ++m)
#pragma unroll
                for (int n = 0; n < 2; ++n) acc[a][b][m][n] = acc_t{};
    bf16x8 At[4][2], B0[2][2], B1[2][2];
    const char* cA = (const char*)g.A + (size_t)cur.pm * tstep; const char* cB = PG8_BPTR(cur);
    PG8_STAGE(PG8_SB(0, 0), cB, voffB); PG8_STAGE(PG8_SB(0, 1), cB + hstep, voffB); PG8_STAGE(PG8_SA(0, 0), cA, voffA); PG8_STAGE(PG8_SA(0, 1), cA + hstep, voffA);
    if (wr == 1) PG8_BAR;
    PG8_WAIT_V(2); PG8_BAR;
    PG8_STAGE(PG8_SB(1, 0), cB + kstep, voffB); PG8_STAGE(PG8_SA(1, 0), cA + kstep, voffA); PG8_STAGE(PG8_SB(1, 1), cB + hstep + kstep, voffB);
    PG8_WAIT_V(6); PG8_BAR;
    for (;;) {
        const bool has_next = S.next(ui + 1, nxt);
        const char* nA = has_next ? (const char*)g.A + (size_t)nxt.pm * tstep : cA; const char* nB = has_next ? PG8_BPTR(nxt) : cB;
        asm volatile(".p2align 8" ::: "memory");
        for (int t = 0; t < nt; t += 2) {
            const bool last = (t == nt - 2);
            const char* a1 = cA + (size_t)(t + 1) * kstep;
            const char* a2 = last ? nA : cA + (size_t)(t + 2) * kstep; const char* b2 = last ? nB : cB + (size_t)(t + 2) * kstep;
            const char* a3 = a2 + kstep; const char* b3 = b2 + kstep;
            PG8_LDB(B0, 0, 0); PG8_LDB(B1, 0, 1); PG8_SCHED; PG8_LDA(At, 0, 0); PG8_STAGE(PG8_SA(1, 1), a1 + hstep, voffA);
            PG8_WAIT_V(8); PG8_WAIT_L(0); PG8_BAR; PG8_MMA(0, 0, At, B0); PG8_MMA(0, 1, At, B1); PG8_BAR; PG8_SCHED;
            PG8_LDA(At, 0, 1); PG8_STAGE(PG8_SB(0, 0), b2, voffB); PG8_STAGE(PG8_SB(0, 1), b2 + hstep, voffB); PG8_STAGE(PG8_SA(0, 0), a2, voffA);
            PG8_WAIT_V(8); PG8_WAIT_L(0); PG8_BAR; PG8_MMA(1, 0, At, B0); PG8_MMA(1, 1, At, B1); PG8_BAR; PG8_SCHED;
            PG8_LDB(B0, 1, 0); PG8_LDB(B1, 1, 1); PG8_SCHED; PG8_LDA(At, 1, 0); PG8_STAGE(PG8_SA(0, 1), a2 + hstep, voffA);
            PG8_WAIT_V(8); PG8_WAIT_L(0); PG8_BAR; PG8_MMA(0, 0, At, B0); PG8_MMA(0, 1, At, B1); PG8_BAR; PG8_SCHED;
            PG8_LDA(At, 1, 1); PG8_STAGE(PG8_SB(1, 0), b3, voffB); PG8_STAGE(PG8_SB(1, 1), b3 + hstep, voffB); PG8_STAGE(PG8_SA(1, 0), a3, voffA);
            PG8_WAIT_V(8); PG8_WAIT_L(0); PG8_BAR; PG8_MMA(1, 0, At, B0); PG8_MMA(1, 1, At, B1); PG8_BAR; PG8_SCHED;
        }
        if constexpr (ALIGN_EPI) { if (wr == 0) PG8_BAR; }
        E(acc, cur, wr, wc, fr, fq);
#ifdef PROBE_EPI2
        if constexpr (EXPERT && !Epi::PERM) { asm volatile("" ::: "memory"); E(acc, cur, wr, wc, fr, fq); }
#endif
        if (!has_next) break;
#pragma unroll
        for (int a = 0; a < 2; ++a)
#pragma unroll
            for (int b = 0; b < 2; ++b)
#pragma unroll
                for (int m = 0; m < 4; ++m)
#pragma unroll
                    for (int n = 0; n < 2; ++n) acc[a][b][m][n] = acc_t{};
        cur = nxt; cA = nA; cB = nB; ++ui;
        if constexpr (ALIGN_EPI) { if (wr == 1) PG8_BAR; }
    }
    PG8_WAIT_V(0);
    if constexpr (!ALIGN_EPI) { if (wr == 0) PG8_BAR; }
    PG8_BAR;
#undef PG8_BPTR
#undef PG8_SA
#undef PG8_SB
#undef PG8_STAGE
#undef PG8_LDA
#undef PG8_LDB
#undef PG8_MMA
#undef PG8_WAIT_V
#undef PG8_WAIT_L
#undef PG8_BAR
#undef PG8_SCHED
}
}

constexpr int NWAVES = 8;
constexpr int D = 1024, NB = 16, SEQ = 4096, CTXL = 256, GW = 64;
constexpr int TL = NB * SEQ, TC = NB * CTXL, TT = TL + TC;
constexpr int PROJ_SRC = 3104, PP = 3328;
constexpr int C_GQ = 0, C_GK = 256, C_GV = 512, C_GR = 1024, C_NQ = 1536, C_NK = 2048, C_NV = 2560, C_LR = 3072;
constexpr int DFF = 2816, DFE = 3584, NE = 8;
constexpr float EPS = 1e-6f;
constexpr int MOE_MAXT = 520, MOE_SLT = 192, MOE_NSL = 3;

constexpr size_t MiB = 1u << 20;
constexpr size_t WS_CTL = 0, CTL_ZERO_BYTES = 1 * MiB;
constexpr size_t WS_MOD = 1 * MiB;
constexpr size_t WS_ROPE = WS_MOD + 2 * 17 * 6144 * 4;
constexpr size_t WS_MOE = 2 * MiB;
constexpr size_t MOE_E = 0, MOE_W = 512 * 1024, MOE_RANK = 1024 * 1024, MOE_POS = 1536 * 1024, MOE_HIST = 2048 * 1024, MOE_ROWTOK = 2048 * 1024 + 16384, MOE_TEXP = MOE_ROWTOK + (size_t)MOE_MAXT * 256 * 4 + 4096, MOE_META = MOE_TEXP + 4096;
constexpr size_t WS_VCT = 6 * MiB;
constexpr size_t WS_SROW = WS_VCT;
constexpr size_t WS_SSORT = WS_VCT + 512 * 1024;
constexpr size_t WS_SB_IN = WS_VCT + 1536 * 1024;
constexpr size_t WS_SB_GU0 = WS_SB_IN + 32 * 1024;
constexpr size_t WS_SB_GU1 = WS_SB_IN + 64 * 1024;
constexpr size_t WS_SB_D0 = WS_SB_IN + 300 * 1024;
constexpr size_t WS_SB_D1 = WS_SB_IN + 320 * 1024;
constexpr float HID_RANGE = 8.0f;
constexpr size_t WS_CTXB = 10 * MiB;
constexpr size_t WS_WIN = 26 * MiB;
constexpr size_t WS_WOUT = WS_WIN + 2 * (size_t)PP * D * 2;
constexpr size_t WS_WGU0 = WS_WOUT + 2 * (size_t)D * D * 2;
constexpr size_t WS_WD0 = WS_WGU0 + (size_t)2 * DFF * D * 2;
constexpr size_t WS_WGU1 = WS_WD0 + (size_t)D * DFF * 2;
constexpr size_t WS_WD1 = WS_WGU1 + (size_t)NE * 2 * DFE * D * 2;
constexpr size_t WS_WEND = WS_WD1 + (size_t)NE * D * DFE * 2;
constexpr size_t WS_H = 228 * MiB;
constexpr size_t WS_BIG = 364 * MiB;
constexpr size_t WS_O = 806 * MiB;
constexpr size_t WS_ASORT = WS_BIG;
constexpr size_t WS_OUTP = WS_BIG + 130 * MiB;
constexpr size_t WS_HIDS = WS_BIG + 390 * MiB;
constexpr size_t WS_HRES_A = 296 * MiB;
constexpr size_t WS_HRES_B = WS_HIDS + (size_t)MOE_SLT * 256 * DFE;
constexpr size_t WS_NAPART = 942 * MiB;
constexpr size_t WS_END = 1024 * MiB;
static_assert(WS_WEND <= WS_H && WS_H + (size_t)TT * D * 2 <= WS_BIG && WS_BIG + (size_t)TT * PP * 2 <= WS_O && WS_O + (size_t)2 * TT * 512 * 2 <= WS_END, "ws map");
static_assert(WS_ASORT + (size_t)MOE_MAXT * 256 * D <= WS_OUTP && WS_OUTP + (size_t)MOE_MAXT * 256 * D * 2 <= WS_HIDS && WS_HIDS + (size_t)MOE_SLT * 256 * DFE <= WS_END && WS_ROPE + 8192 <= WS_MOE && MOE_META + 256 <= 4 * MiB, "ws map 2");
static_assert(WS_H + (size_t)TT * D <= WS_HRES_A && WS_HRES_A + (size_t)(TL / 2) * D * 2 <= WS_BIG && WS_HRES_B + (size_t)(TL / 2) * D * 2 <= WS_END && MOE_SLT * MOE_NSL >= MOE_MAXT, "ws map 3");
constexpr int CW_TMO = 0, CW_BAR = 4096;

constexpr int RING_OFF = 0, RING_BYTES = 131072;
constexpr int IDX_OFF = 159744, IDX_BYTES = 256 * 4;
constexpr int LDSCTL_OFF = IDX_OFF + 1024, MISC_OFF = LDSCTL_OFF + 64, PTAB_OFF = MISC_OFF + 128;
constexpr int LDS_BYTES = 163840;
static_assert(PTAB_OFF + 256 <= LDS_BYTES, "LDS map");

#define LAS __attribute__((address_space(3)))
typedef unsigned short bf16;
typedef float f32x4 __attribute__((ext_vector_type(4)));
typedef short bf16x8 __attribute__((ext_vector_type(8)));
typedef short s16x4 __attribute__((ext_vector_type(4)));
typedef unsigned u32x4 __attribute__((ext_vector_type(4)));
typedef unsigned u32x2 __attribute__((ext_vector_type(2)));
#define RLX_AGENT __ATOMIC_RELAXED, __HIP_MEMORY_SCOPE_AGENT
#define LDS_WAIT() asm volatile("s_waitcnt lgkmcnt(0)" ::: "memory")
#define VM_WAIT() asm volatile("s_waitcnt vmcnt(0)" ::: "memory")
typedef float f32x2 __attribute__((ext_vector_type(2)));
typedef __bf16 bf16x2_t __attribute__((ext_vector_type(2)));
__device__ __forceinline__ unsigned pk2(float lo, float hi) { const f32x2 v = {lo, hi}; return __builtin_bit_cast(unsigned, __builtin_convertvector(v, bf16x2_t)); }
__device__ __forceinline__ unsigned f2bf(float f) { return pk2(f, 0.f) & 0xffffu; }
__device__ __forceinline__ float bflo(unsigned w) { return __builtin_bit_cast(float, w << 16); }
__device__ __forceinline__ float bfhi(unsigned w) { return __builtin_bit_cast(float, w & 0xffff0000u); }
__device__ __forceinline__ f32x4 mfma16(bf16x8 a, bf16x8 b, f32x4 c) { return __builtin_amdgcn_mfma_f32_16x16x32_bf16(a, b, c, 0, 0, 0); }
__device__ __forceinline__ s16x4 tr_read(const LAS unsigned char* p) { return __builtin_amdgcn_ds_read_tr16_b64_v4i16((LAS s16x4*)p); }

#define XB_TMO      128
#define XB_XCNT(j)  (256  + 64 * (j))
#define XB_XSUB(j)  (1280 + 64 * (j))
#define XB_XGEN(j)  (2304 + 64 * (j))
#define XB_TOP      3328
#define XB_TOPGEN   3392
#define XCD_BAR_WORDS 3456
#define XB_SPIN_CAP (1u << 18)
__device__ __forceinline__ unsigned xb_ld(unsigned* p)              { return __hip_atomic_load(p, __ATOMIC_RELAXED, __HIP_MEMORY_SCOPE_AGENT); }
__device__ __forceinline__ unsigned xb_add(unsigned* p, unsigned v) { return __hip_atomic_fetch_add(p, v, __ATOMIC_RELAXED, __HIP_MEMORY_SCOPE_AGENT); }
__device__ __forceinline__ unsigned xb_xcc_id() { return (unsigned)__builtin_amdgcn_s_getreg((3 << 11) | 20) & 0xFu; }
#define XB_SPIN(cond, bar) do { unsigned _sp = 0; while (cond) { __builtin_amdgcn_s_sleep(1); \
    if ((++_sp & 255u) == 0u) { if (xb_ld(&(bar)[XB_TMO])) break; if (_sp > XB_SPIN_CAP) { atomicAdd(&(bar)[XB_TMO], 1u); break; } } } } while (0)
struct XcdBarrier { unsigned* bar; unsigned x; volatile LAS unsigned* st; };
__device__ __forceinline__ XcdBarrier xcd_barrier_post(unsigned* bar, volatile LAS unsigned* st) {
    XcdBarrier b; b.bar = bar; b.x = xb_xcc_id(); b.st = st;
    if (threadIdx.x == 0) (void)xb_add(&bar[XB_XCNT(b.x)], 1u);
    return b;
}
__device__ __forceinline__ void xcd_barrier_complete(unsigned* bar, unsigned x, unsigned& nloc, unsigned& nx) {
    const unsigned G = gridDim.x * gridDim.y * gridDim.z;
    unsigned sum, cnt, mine, sp = 0u;
    for (;;) {
        sum = 0u; cnt = 0u; mine = 0u;
#pragma unroll
        for (unsigned j = 0; j < 16; ++j) { const unsigned c = xb_ld(&bar[XB_XCNT(j)]); sum += c; cnt += (c > 0u) ? 1u : 0u; mine = (j == x) ? c : mine; }
        if (sum == G) break;
        __builtin_amdgcn_s_sleep(1);
        if ((++sp & 255u) == 0u) { if (xb_ld(&bar[XB_TMO])) break; if (sp > XB_SPIN_CAP) { atomicAdd(&bar[XB_TMO], 1u); break; } }
    }
    nloc = mine > 0u ? mine : 1u; nx = cnt > 0u ? cnt : 1u;
}
__device__ __forceinline__ void xcd_barrier(const XcdBarrier& b) {
    asm volatile("s_waitcnt vmcnt(0)" ::: "memory");
    __syncthreads();
    if (threadIdx.x == 0) {
        unsigned* bar = b.bar;
        __builtin_amdgcn_s_waitcnt(0);
        unsigned nloc = b.st[0], nx = b.st[1];
        if (nloc == 0u) { xcd_barrier_complete(bar, b.x, nloc, nx); b.st[0] = nloc; b.st[1] = nx; }
        const unsigned old = xb_add(&bar[XB_XSUB(b.x)], 1u);
        const unsigned gen = old / nloc;
        if (old + 1u == (gen + 1u) * nloc) {
            __builtin_amdgcn_fence(__ATOMIC_RELEASE, "agent");
            asm volatile("s_waitcnt vmcnt(0)" ::: "memory");
            const unsigned og = xb_add(&bar[XB_TOP], 1u);
            const unsigned tg = og / nx;
            if (og + 1u == (tg + 1u) * nx) xb_add(&bar[XB_TOPGEN], 1u);
            else XB_SPIN(xb_ld(&bar[XB_TOPGEN]) == tg, bar);
            __builtin_amdgcn_fence(__ATOMIC_ACQUIRE, "agent");
            xb_add(&bar[XB_XGEN(b.x)], 1u);
            asm volatile("s_waitcnt vmcnt(0)" ::: "memory");
        } else {
            XB_SPIN(xb_ld(&bar[XB_XGEN(b.x)]) == gen, bar);
            __builtin_amdgcn_fence(__ATOMIC_ACQUIRE, "agent");
            asm volatile("s_waitcnt vmcnt(0)" ::: "memory");
        }
    }
    __syncthreads();
}

struct Frame {
    LAS unsigned char* lds;
    int tid, lane, wave, vcu, G;
    unsigned char* ws;
    float* out;
    __device__ __forceinline__ const float* inp(int i) const { const LAS unsigned* pt = (const LAS unsigned*)(lds + PTAB_OFF) + 2 * i; const unsigned lo = __builtin_amdgcn_readfirstlane(pt[0]), hi = __builtin_amdgcn_readfirstlane(pt[1]); return (const float*)(((unsigned long long)hi << 32) | lo); }
};
enum { I_X = 0, I_C, I_CTX, I_CCTX, I_WADA, I_BADA, I_GPREMIX, I_GPOSTMIX, I_GPREFFN, I_GPOSTFFN, I_WIN, I_GWG, I_GBG, I_GGN, I_RPB, I_WOUT, I_FWG, I_FWU, I_FWD, I_MWR, I_MWG, I_MWU, I_MWD };

template <int CTRL> __device__ __forceinline__ float dpp_f(float v) { return __builtin_bit_cast(float, __builtin_amdgcn_update_dpp(0, __builtin_bit_cast(int, v), CTRL, 0xf, 0xf, true)); }
struct OpAdd { static __device__ __forceinline__ float f(float a, float b) { return a + b; } };
struct OpMax { static __device__ __forceinline__ float f(float a, float b) { return fmaxf(a, b); } };
template <class Op> __device__ __forceinline__ float red_x16(float v) { const unsigned u = __builtin_bit_cast(unsigned, v); const auto r = __builtin_amdgcn_permlane16_swap(u, u, false, false);
    return Op::f(__builtin_bit_cast(float, (unsigned)r[0]), __builtin_bit_cast(float, (unsigned)r[1])); }
template <class Op> __device__ __forceinline__ float red_x32(float v) { const unsigned u = __builtin_bit_cast(unsigned, v); const auto r = __builtin_amdgcn_permlane32_swap(u, u, false, false);
    return Op::f(__builtin_bit_cast(float, (unsigned)r[0]), __builtin_bit_cast(float, (unsigned)r[1])); }
template <class Op> __device__ __forceinline__ float red_row16(float v) {
    v = Op::f(v, dpp_f<0xB1>(v)); v = Op::f(v, dpp_f<0x4E>(v)); v = Op::f(v, dpp_f<0x141>(v)); return Op::f(v, dpp_f<0x140>(v)); }
template <class Op> __device__ __forceinline__ float red_wave(float v) { return red_x32<Op>(red_x16<Op>(red_row16<Op>(v))); }
__device__ __forceinline__ float wave_sum(float v) { return red_wave<OpAdd>(v); }

__device__ __forceinline__ int dst_row(int n, int mode) {
    if (mode == 0) return n;
    if (mode == 1) return n < 1536 ? n : (n < 1568 ? n + 1536 : n - 32);
    return 32 * (n >> 4) + (n & 15) + (mode == 3 ? 16 : 0);
}
__device__ __forceinline__ void p0_transpose_item(const float* W, int K, int N, bf16* WT, int mode, LAS float* scr, int item, int lane) {
    const int nblk = N / 32, kb = item / nblk, nb = item % nblk, k0 = 64 * kb, n0 = 32 * nb;
    const int kr = lane >> 3, n4 = lane & 7;
    f32x4 v[8];
#pragma unroll
    for (int i = 0; i < 8; ++i) v[i] = *(const f32x4*)(W + (size_t)(k0 + 8 * i + kr) * N + n0 + 4 * n4);
#pragma unroll
    for (int i = 0; i < 8; ++i) { LAS float* d = scr + (8 * i + kr) * 33 + 4 * n4; d[0] = v[i][0]; d[1] = v[i][1]; d[2] = v[i][2]; d[3] = v[i][3]; }
    LDS_WAIT(); asm volatile("" ::: "memory");
    const int c = lane & 7;
#pragma unroll
    for (int j = 0; j < 4; ++j) { const int n = (lane >> 3) + 8 * j; const LAS float* s = scr + (8 * c) * 33 + n;
        u32x4 o; o.x = pg8::cvt_pk_bf16(s[0 * 33], s[1 * 33]); o.y = pg8::cvt_pk_bf16(s[2 * 33], s[3 * 33]); o.z = pg8::cvt_pk_bf16(s[4 * 33], s[5 * 33]); o.w = pg8::cvt_pk_bf16(s[6 * 33], s[7 * 33]);
        *(u32x4*)(WT + (size_t)dst_row(n0 + n, mode) * K + k0 + 8 * c) = o; }
    LDS_WAIT(); asm volatile("" ::: "memory");
}

__device__ __forceinline__ void p0_quant_wgitem(const float* W, int K, int N, signed char* W8, float* sb, int mode, LAS float* scr, LAS float* AM, int nb, int wave, int lane) {
    const int n0 = 32 * nb, kr = lane >> 3, n4 = lane & 7, nsub = K / 64;
    f32x4 am = (f32x4){0.f, 0.f, 0.f, 0.f};
    for (int j = wave; j < nsub; j += 8) { const int k0 = 64 * j;
#pragma unroll
        for (int i = 0; i < 8; ++i) { const f32x4 v = *(const f32x4*)(W + (size_t)(k0 + 8 * i + kr) * N + n0 + 4 * n4);
            am[0] = fmaxf(am[0], fabsf(v[0])); am[1] = fmaxf(am[1], fabsf(v[1])); am[2] = fmaxf(am[2], fabsf(v[2])); am[3] = fmaxf(am[3], fabsf(v[3])); } }
#pragma unroll
    for (int q = 0; q < 4; ++q) { float a = am[q]; a = fmaxf(a, dpp_f<0x128>(a)); a = red_x32<OpMax>(red_x16<OpMax>(a)); am[q] = a; }
    if (kr == 0) *(LAS f32x4*)(AM + wave * 32 + 4 * n4) = am;
    __syncthreads();
#pragma unroll
    for (int w2 = 0; w2 < 8; ++w2) { const f32x4 o = *(const LAS f32x4*)(AM + w2 * 32 + 4 * n4); am[0] = fmaxf(am[0], o[0]); am[1] = fmaxf(am[1], o[1]); am[2] = fmaxf(am[2], o[2]); am[3] = fmaxf(am[3], o[3]); }
    f32x4 inv;
#pragma unroll
    for (int q = 0; q < 4; ++q) inv[q] = am[q] > 0.f ? 127.0f / am[q] : 0.f;
    if (wave == 0 && kr == 0) {
#pragma unroll
        for (int q = 0; q < 4; ++q) sb[dst_row(n0 + 4 * n4 + q, mode)] = am[q] * (1.0f / 127.0f); }
    const int c = lane & 7;
    for (int j = wave; j < nsub; j += 8) { const int k0 = 64 * j;
        f32x4 v[8];
#pragma unroll
        for (int i = 0; i < 8; ++i) v[i] = *(const f32x4*)(W + (size_t)(k0 + 8 * i + kr) * N + n0 + 4 * n4) * inv;
#pragma unroll
        for (int i = 0; i < 8; ++i) { LAS float* d = scr + (8 * i + kr) * 33 + 4 * n4; d[0] = v[i][0]; d[1] = v[i][1]; d[2] = v[i][2]; d[3] = v[i][3]; }
        LDS_WAIT(); asm volatile("" ::: "memory");
#pragma unroll
        for (int jj = 0; jj < 4; ++jj) { const int n = (lane >> 3) + 8 * jj; const LAS float* s = scr + (8 * c) * 33 + n;
            unsigned lo = 0u, hi = 0u;
#pragma unroll
            for (int e = 0; e < 4; ++e) { lo |= ((unsigned)(int)__builtin_rintf(s[e * 33]) & 255u) << (8 * e); hi |= ((unsigned)(int)__builtin_rintf(s[(4 + e) * 33]) & 255u) << (8 * e); }
            *(u32x2*)(W8 + (size_t)dst_row(n0 + n, mode) * K + k0 + 8 * c) = (u32x2){lo, hi}; }
        LDS_WAIT(); asm volatile("" ::: "memory");
    }
    __syncthreads();
}
__device__ __forceinline__ void p0_prologue(Frame& F) {
    if (F.vcu < 192) {
        LAS float* SL = (LAS float*)(F.lds);
        LAS float* PS = (LAS float*)(F.lds + 17 * 1024 * 4);
        for (int i = F.tid; i < 17 * 1024; i += 512) { const float v = i < 16 * 1024 ? F.inp(I_C)[i] : F.inp(I_CCTX)[i - 16 * 1024]; SL[i] = v / (1.0f + __expf(-v)); }
        __syncthreads();
        const int l = F.vcu / 96, cb = F.vcu % 96, col = 64 * cb + F.lane;
        const float* W = F.inp(I_WADA) + (size_t)l * D * 6144 + col;
        float acc[17];
#pragma unroll
        for (int r = 0; r < 17; ++r) acc[r] = 0.f;
#pragma unroll 4
        for (int k4 = 0; k4 < 32; ++k4) { const int k = 128 * F.wave + 4 * k4;
            const float w0 = W[(size_t)(k + 0) * 6144], w1 = W[(size_t)(k + 1) * 6144], w2 = W[(size_t)(k + 2) * 6144], w3 = W[(size_t)(k + 3) * 6144];
#pragma unroll
            for (int r = 0; r < 17; ++r) { const f32x4 s = *(const LAS f32x4*)(SL + r * 1024 + k); acc[r] += s[0] * w0 + s[1] * w1 + s[2] * w2 + s[3] * w3; } }
#pragma unroll
        for (int r = 0; r < 17; ++r) PS[(F.wave * 17 + r) * 64 + F.lane] = acc[r];
        __syncthreads();
        float* mod = (float*)(F.ws + WS_MOD);
        for (int i = F.tid; i < 17 * 64; i += 512) { const int r = i >> 6, c = i & 63; float s = 0.f;
#pragma unroll
            for (int w = 0; w < 8; ++w) s += PS[(w * 17 + r) * 64 + c];
            mod[((size_t)l * 17 + r) * 6144 + 64 * cb + c] = s + F.inp(I_BADA)[l * 6144 + 64 * cb + c]; }
        __syncthreads();
    }
    if (F.vcu == 255) { float* rt = (float*)(F.ws + WS_ROPE);
        for (int i = F.tid; i < 1024; i += 512) { const int pos = i >> 4, fi = i & 15; const float inv = exp2f(-(float)fi * (13.287712379549449f / 16.0f)); const float a = (float)pos * inv; rt[2 * i] = cosf(a); rt[2 * i + 1] = sinf(a); } }
    { signed char* win = (signed char*)(F.ws + WS_WIN); const int gt = F.vcu * 512 + F.tid, NT = F.G * 512;
      for (int i = gt; i < 2 * 224 * 64; i += NT) { const int l = i / (224 * 64), r = i % (224 * 64); *(u32x4*)(win + ((size_t)l * PP + PROJ_SRC) * D + (size_t)r * 16) = (u32x4){0u, 0u, 0u, 0u}; }
      if (gt < 2 * 224) ((float*)(F.ws + WS_SB_IN))[(gt / 224) * PP + PROJ_SRC + gt % 224] = 0.f; }
    LAS float* scr = (LAS float*)(F.lds + RING_OFF + F.wave * 16384);
    LAS float* AM = (LAS float*)(F.lds + 140000 + 0);
    constexpr int QA = 97, QC = 88, QE = 112, QF = 32;
    constexpr int NWI = 8 * QF + QF + 16 * QE + 2 * QC + 2 * QA;
    for (int it = F.vcu; it < NWI; it += F.G) {
        int r = it;
        if (r < 8 * QF) { const int e = r / QF; p0_quant_wgitem(F.inp(I_MWD) + (size_t)e * DFE * D, DFE, D, (signed char*)(F.ws + WS_WD1) + (size_t)e * D * DFE, (float*)(F.ws + WS_SB_D1) + (size_t)e * D, 0, scr, AM, r % QF, F.wave, F.lane); continue; } r -= 8 * QF;
        if (r < QF) { p0_quant_wgitem(F.inp(I_FWD), DFF, D, (signed char*)(F.ws + WS_WD0), (float*)(F.ws + WS_SB_D0), 0, scr, AM, r, F.wave, F.lane); continue; } r -= QF;
        if (r < 16 * QE) { const int m = r / QE, e = m >> 1, w = m & 1; p0_quant_wgitem(F.inp(w ? I_MWU : I_MWG) + (size_t)e * D * DFE, D, DFE, (signed char*)(F.ws + WS_WGU1) + (size_t)e * 2 * DFE * D, (float*)(F.ws + WS_SB_GU1) + (size_t)e * 2 * DFE, 2 + w, scr, AM, r % QE, F.wave, F.lane); continue; } r -= 16 * QE;
        if (r < 2 * QC) { const int w = r / QC; p0_quant_wgitem(F.inp(w ? I_FWU : I_FWG), D, DFF, (signed char*)(F.ws + WS_WGU0), (float*)(F.ws + WS_SB_GU0), 2 + w, scr, AM, r % QC, F.wave, F.lane); continue; } r -= 2 * QC;
        { const int l = r / QA; p0_quant_wgitem(F.inp(I_WIN) + (size_t)l * D * PROJ_SRC, D, PROJ_SRC, (signed char*)(F.ws + WS_WIN) + (size_t)l * PP * D, (float*)(F.ws + WS_SB_IN) + (size_t)l * PP, 1, scr, AM, r % QA, F.wave, F.lane); }
    }
    const int gw = F.vcu * NWAVES + F.wave, NGW = F.G * NWAVES;
    constexpr int IB = 16 * 32;
    for (int it = gw; it < 2 * IB; it += NGW) { const int l = it / IB; p0_transpose_item(F.inp(I_WOUT) + (size_t)l * D * D, D, D, (bf16*)(F.ws + WS_WOUT) + (size_t)l * D * D, 0, scr, it % IB, F.lane); }
}

struct Row { f32x4 v[4]; };
__device__ __forceinline__ Row ld_f32(const float* p, int lane) { Row r;
#pragma unroll
    for (int j = 0; j < 4; ++j) r.v[j] = __builtin_nontemporal_load((const f32x4*)(p + 4 * lane + 256 * j));
    return r; }
__device__ __forceinline__ void st_f32(float* p, int lane, const Row& r) {
#pragma unroll
    for (int j = 0; j < 4; ++j) __builtin_nontemporal_store(r.v[j], (f32x4*)(p + 4 * lane + 256 * j)); }
__device__ __forceinline__ Row ld_bf16(const bf16* p, int lane) { Row r;
#pragma unroll
    for (int j = 0; j < 4; ++j) { const u32x2 w = *(const u32x2*)(p + 4 * lane + 256 * j); r.v[j] = (f32x4){bflo(w.x), bfhi(w.x), bflo(w.y), bfhi(w.y)}; }
    return r; }
__device__ __forceinline__ void st_bf16(bf16* p, int lane, const Row& r) {
#pragma unroll
    for (int j = 0; j < 4; ++j) { u32x2 w; w.x = pk2(r.v[j][0], r.v[j][1]); w.y = pk2(r.v[j][2], r.v[j][3]); *(u32x2*)(p + 4 * lane + 256 * j) = w; } }
__device__ __forceinline__ Row ld_bf16nt(const bf16* p, int lane) { Row r;
#pragma unroll
    for (int j = 0; j < 4; ++j) { const u32x2 w = __builtin_nontemporal_load((const u32x2*)(p + 4 * lane + 256 * j)); r.v[j] = (f32x4){bflo(w.x), bfhi(w.x), bflo(w.y), bfhi(w.y)}; }
    return r; }
__device__ __forceinline__ void st_bf16nt(bf16* p, int lane, const Row& r) {
#pragma unroll
    for (int j = 0; j < 4; ++j) { u32x2 w; w.x = pk2(r.v[j][0], r.v[j][1]); w.y = pk2(r.v[j][2], r.v[j][3]); __builtin_nontemporal_store(w, (u32x2*)(p + 4 * lane + 256 * j)); } }
__device__ __forceinline__ bf16* hres1(Frame& F, int row) { return (bf16*)(F.ws + (row < TL / 2 ? WS_HRES_A : WS_HRES_B - (size_t)(TL / 2) * D * 2)) + (size_t)row * D; }
__device__ __forceinline__ float row_rinv(const Row& r) { float s = 0.f;
#pragma unroll
    for (int j = 0; j < 4; ++j) s += (r.v[j][0] * r.v[j][0] + r.v[j][1] * r.v[j][1]) + (r.v[j][2] * r.v[j][2] + r.v[j][3] * r.v[j][3]);
    return 1.0f / sqrtf(wave_sum(s) * (1.0f / D) + EPS); }
__device__ __forceinline__ float wave_max(float v) { return red_wave<OpMax>(v); }
__device__ __forceinline__ void st_q8(signed char* p, float* srow, int lane, const Row& r) {
    float am = 0.f;
#pragma unroll
    for (int j = 0; j < 4; ++j) am = fmaxf(am, fmaxf(fmaxf(fabsf(r.v[j][0]), fabsf(r.v[j][1])), fmaxf(fabsf(r.v[j][2]), fabsf(r.v[j][3]))));
    am = wave_max(am);
    const float inv = am > 0.f ? 127.0f / am : 0.f;
#pragma unroll
    for (int j = 0; j < 4; ++j) { unsigned w = 0u;
#pragma unroll
        for (int e = 0; e < 4; ++e) w |= ((unsigned)(int)__builtin_rintf(r.v[j][e] * inv) & 255u) << (8 * e);
        *(unsigned*)(p + 4 * lane + 256 * j) = w; }
    if (lane == 0) *srow = am * (1.0f / 127.0f);
}
__device__ __forceinline__ const float* modp(Frame& F, int l, int r, int which) { return (const float*)(F.ws + WS_MOD) + (((size_t)l * 17 + r) * 6 + which) * 1024; }

__device__ __forceinline__ void t1_prenorm(Frame& F) {
    const int gw = F.vcu * NWAVES + F.wave; signed char* H8 = (signed char*)(F.ws + WS_H); float* SR = (float*)(F.ws + WS_SROW);
    const Row g = ld_f32(F.inp(I_GPREMIX), F.lane);
    for (int seg = 0; seg < 2; ++seg) {
        const int r0 = seg ? TL + 2 * gw : 32 * gw, nr = seg ? 2 : 32, mr = seg ? 16 : (gw >> 7);
        const Row sc = ld_f32(modp(F, 0, mr, 1), F.lane), sh = ld_f32(modp(F, 0, mr, 0), F.lane);
        const float* src0 = seg ? F.inp(I_CTX) + (size_t)(r0 - TL) * D : F.inp(I_X) + (size_t)r0 * D;
        Row xn = ld_f32(src0, F.lane);
        for (int i = 0; i < nr; ++i) { const int row = r0 + i;
            Row x = xn; if (i + 1 < nr) xn = ld_f32(src0 + (size_t)(i + 1) * D, F.lane);
            const float ri = row_rinv(x);
#pragma unroll
            for (int j = 0; j < 4; ++j) x.v[j] = (x.v[j] * ri * g.v[j]) * (1.0f + sc.v[j]) + sh.v[j];
            st_q8(H8 + (size_t)row * D, SR + row, F.lane, x); }
    }
}
__device__ __forceinline__ void t2_postmix(Frame& F, int l) {
    const int gw = F.vcu * NWAVES + F.wave; signed char* H8 = (signed char*)(F.ws + WS_H); float* SR = (float*)(F.ws + WS_SROW); const bf16* Y = (const bf16*)(F.ws + WS_BIG);
    float* ctxb = (float*)(F.ws + WS_CTXB);
    const Row gpm = ld_f32(F.inp(I_GPOSTMIX) + l * D, F.lane), gpf = ld_f32(F.inp(I_GPREFFN) + l * D, F.lane);
    LAS float* WR = (LAS float*)(F.lds);
    LAS int* CNT = (LAS int*)(F.lds + 32768);
    if (l == 1) { for (int i = F.tid; i < 8192; i += 512) WR[i] = F.inp(I_MWR)[i]; if (F.tid < 8) CNT[F.tid] = 0; __syncthreads(); }
    const int nseg = l == 0 ? 2 : 1;
    for (int seg = 0; seg < nseg; ++seg) {
        const int r0 = seg ? TL + 2 * gw : 32 * gw, nr = seg ? 2 : 32, mr = seg ? 16 : (gw >> 7);
        const Row gt1 = ld_f32(modp(F, l, mr, 2), F.lane), sc2 = ld_f32(modp(F, l, mr, 4), F.lane), sh2 = ld_f32(modp(F, l, mr, 3), F.lane);
        const float* xs0 = seg ? F.inp(I_CTX) + (size_t)(r0 - TL) * D : F.inp(I_X) + (size_t)r0 * D;
        const bf16* xb0 = (const bf16*)F.out + (size_t)r0 * D;
        bf16* xdb = l == 0 ? (bf16*)F.out : hres1(F, r0) - (size_t)r0 * D;
        Row yn = ld_bf16(Y + (size_t)r0 * D, F.lane), xn = l == 0 ? ld_f32(xs0, F.lane) : ld_bf16nt(xb0, F.lane);
        for (int i = 0; i < nr; ++i) { const int row = r0 + i;
            const Row y = yn; Row x = xn;
            if (i + 1 < nr) { yn = ld_bf16(Y + (size_t)(row + 1) * D, F.lane); xn = l == 0 ? ld_f32(xs0 + (size_t)(i + 1) * D, F.lane) : ld_bf16nt(xb0 + (size_t)(i + 1) * D, F.lane); }
            const float ry = row_rinv(y);
#pragma unroll
            for (int j = 0; j < 4; ++j) x.v[j] = x.v[j] + gt1.v[j] * (y.v[j] * ry * gpm.v[j]);
            if (seg) st_f32(ctxb + (size_t)(row - TL) * D, F.lane, x); else st_bf16nt(xdb + (size_t)row * D, F.lane, x);
            const float r2 = row_rinv(x);
#pragma unroll
            for (int j = 0; j < 4; ++j) x.v[j] = (x.v[j] * r2 * gpf.v[j]) * (1.0f + sc2.v[j]) + sh2.v[j];
            st_q8(H8 + (size_t)row * D, SR + row, F.lane, x);
            if (l == 1) {
                float lg[8];
#pragma unroll
                for (int e = 0; e < 8; ++e) lg[e] = 0.f;
#pragma unroll
                for (int j = 0; j < 4; ++j)
#pragma unroll
                    for (int q = 0; q < 4; ++q) { const LAS float* w = WR + (4 * F.lane + 256 * j + q) * 8; const f32x4 w0 = *(const LAS f32x4*)w, w1 = *(const LAS f32x4*)(w + 4); const float hv = x.v[j][q];
                        lg[0] += hv * w0[0]; lg[1] += hv * w0[1]; lg[2] += hv * w0[2]; lg[3] += hv * w0[3]; lg[4] += hv * w1[0]; lg[5] += hv * w1[1]; lg[6] += hv * w1[2]; lg[7] += hv * w1[3]; }
#pragma unroll
                for (int e = 0; e < 8; ++e) lg[e] = wave_sum(lg[e]);
                int i1 = 0; float v1 = lg[0];
#pragma unroll
                for (int e = 1; e < 8; ++e) if (lg[e] > v1) { v1 = lg[e]; i1 = e; }
                int i2 = -1; float v2 = -3.0e38f;
#pragma unroll
                for (int e = 0; e < 8; ++e) if (e != i1 && lg[e] > v2) { v2 = lg[e]; i2 = e; }
                if (i2 < 0) i2 = i1 == 0 ? 1 : 0;
                const float w2 = 1.0f / (1.0f + __expf(v1 - v2)), w1 = 1.0f - w2;
                if (F.lane == 0) { int* te = (int*)(F.ws + WS_MOE + MOE_E); float* tw = (float*)(F.ws + WS_MOE + MOE_W); int* tr = (int*)(F.ws + WS_MOE + MOE_RANK);
                    te[2 * row] = i1; te[2 * row + 1] = i2; tw[2 * row] = w1; tw[2 * row + 1] = w2;
                    tr[2 * row] = atomicAdd((int*)(CNT + i1), 1); tr[2 * row + 1] = atomicAdd((int*)(CNT + i2), 1); }
            }
        }
    }
    if (l == 1) { __syncthreads(); if (F.tid < 8) ((int*)(F.ws + WS_MOE + MOE_HIST))[F.vcu * 8 + F.tid] = CNT[F.tid]; }
}
__device__ __forceinline__ void m2_lists(Frame& F) {
    LAS int* L = (LAS int*)(F.lds);
    const int* hist = (const int*)(F.ws + WS_MOE + MOE_HIST);
    if (F.wave == 0) {
        int tot[8], pre[8];
#pragma unroll
        for (int e = 0; e < 8; ++e) { int t = 0, p = 0;
#pragma unroll
            for (int q = 0; q < 4; ++q) { const int wg = F.lane + 64 * q; const int hv = hist[wg * 8 + e]; t += hv; p += (wg < F.vcu) ? hv : 0; }
#pragma unroll
            for (int o = 1; o < 64; o <<= 1) { t += __shfl_xor(t, o); p += __shfl_xor(p, o); }
            tot[e] = t; pre[e] = p; }
        if (F.lane == 0) { int base = 0;
#pragma unroll
            for (int e = 0; e < 8; ++e) { L[e] = base * 256; L[8 + e] = pre[e]; L[16 + e] = tot[e]; base += (tot[e] + 255) >> 8; }
            L[24] = base; }
    }
    __syncthreads();
    const int* te = (const int*)(F.ws + WS_MOE + MOE_E); const int* tr = (const int*)(F.ws + WS_MOE + MOE_RANK);
    int* tp = (int*)(F.ws + WS_MOE + MOE_POS); int* rtok = (int*)(F.ws + WS_MOE + MOE_ROWTOK);
    { const int pair = F.vcu * 512 + F.tid;
      const int e = min(max(te[pair], 0), 7); const int pos = min(max(L[e] + L[8 + e] + tr[pair], 0), MOE_MAXT * 256 - 1); tp[pair] = pos; rtok[pos] = pair >> 1; }
    if (F.vcu < 8) { const int e = F.vcu; const int cnt = L[16 + e], end = ((cnt + 255) >> 8) << 8; for (int i = cnt + F.tid; i < end; i += 512) rtok[L[e] + i] = 0; }
    if (F.vcu == 8) { int* tex = (int*)(F.ws + WS_MOE + MOE_TEXP);
        for (int t = F.tid; t < MOE_MAXT + 8; t += 512) { int e = 7;
#pragma unroll
            for (int q = 7; q >= 1; --q) if (t * 256 < L[q]) e = q - 1;
            tex[t] = e; }
        if (F.tid == 0) ((int*)(F.ws + WS_MOE + MOE_META))[0] = L[24]; }
}
__device__ __forceinline__ void t3_postffn(Frame& F, int l) {
    const int gw = F.vcu * NWAVES + F.wave; signed char* H8 = (signed char*)(F.ws + WS_H); float* SR = (float*)(F.ws + WS_SROW); float* ctxb = (float*)(F.ws + WS_CTXB);
    const Row gpo = ld_f32(F.inp(I_GPOSTFFN) + l * D, F.lane);
    const int nseg = l == 0 ? 2 : 1;
    for (int seg = 0; seg < nseg; ++seg) {
        const int r0 = seg ? TL + 2 * gw : 32 * gw, nr = seg ? 2 : 32, mr = seg ? 16 : (gw >> 7);
        const Row gt2 = ld_f32(modp(F, l, mr, 5), F.lane);
        Row gn, scn, shn;
        if (l == 0) { gn = ld_f32(F.inp(I_GPREMIX) + D, F.lane); scn = ld_f32(modp(F, 1, mr, 1), F.lane); shn = ld_f32(modp(F, 1, mr, 0), F.lane); }
        const int* tp = (const int*)(F.ws + WS_MOE + MOE_POS); const float* tw = (const float*)(F.ws + WS_MOE + MOE_W); const bf16* OP = (const bf16*)(F.ws + WS_OUTP); const bf16* FB = (const bf16*)(F.ws + WS_O);
        float* xp0 = seg ? ctxb + (size_t)(r0 - TL) * D : F.out + (size_t)r0 * D;
        const bf16* xb0 = l == 0 ? (const bf16*)F.out + (size_t)r0 * D : hres1(F, r0);
        const bool xf = seg != 0;
        int pan = 0, pbn = 0; float wan = 0.f, wbn = 0.f, wa = 0.f, wb = 0.f;
        Row fan, fbn, xn;
        if (l == 0) fan = ld_bf16(FB + (size_t)r0 * D, F.lane);
        else { const int pa0 = min(max(tp[2 * r0], 0), MOE_MAXT * 256 - 1), pb0 = min(max(tp[2 * r0 + 1], 0), MOE_MAXT * 256 - 1); wa = tw[2 * r0]; wb = tw[2 * r0 + 1]; fan = ld_bf16(OP + (size_t)pa0 * D, F.lane); fbn = ld_bf16(OP + (size_t)pb0 * D, F.lane);
            if (nr > 1) { pan = min(max(tp[2 * r0 + 2], 0), MOE_MAXT * 256 - 1); pbn = min(max(tp[2 * r0 + 3], 0), MOE_MAXT * 256 - 1); wan = tw[2 * r0 + 2]; wbn = tw[2 * r0 + 3]; } }
        xn = xf ? ld_f32(xp0, F.lane) : ld_bf16nt(xb0, F.lane);
        for (int i = 0; i < nr; ++i) { const int row = r0 + i;
            Row f = fan; Row x = xn; const float wac = wa, wbc = wb;
            if (l == 1) {
#pragma unroll
                for (int j = 0; j < 4; ++j) f.v[j] = fan.v[j] * wac + fbn.v[j] * wbc; }
            if (i + 1 < nr) {
                if (l == 0) fan = ld_bf16(FB + (size_t)(row + 1) * D, F.lane);
                else { fan = ld_bf16(OP + (size_t)pan * D, F.lane); fbn = ld_bf16(OP + (size_t)pbn * D, F.lane); wa = wan; wb = wbn;
                    if (i + 2 < nr) { pan = min(max(tp[2 * row + 4], 0), MOE_MAXT * 256 - 1); pbn = min(max(tp[2 * row + 5], 0), MOE_MAXT * 256 - 1); wan = tw[2 * row + 4]; wbn = tw[2 * row + 5]; } }
                xn = xf ? ld_f32(xp0 + (size_t)(i + 1) * D, F.lane) : ld_bf16nt(xb0 + (size_t)(i + 1) * D, F.lane); }
            const float rf = row_rinv(f);
            float* xp = xp0 + (size_t)i * D;
#pragma unroll
            for (int j = 0; j < 4; ++j) x.v[j] = x.v[j] + gt2.v[j] * (f.v[j] * rf * gpo.v[j]);
            if (xf || l == 1) st_f32(xp, F.lane, x); else st_bf16nt((bf16*)F.out + (size_t)row * D, F.lane, x);
            if (l == 0) { const float r3 = row_rinv(x);
#pragma unroll
                for (int j = 0; j < 4; ++j) x.v[j] = (x.v[j] * r3 * gn.v[j]) * (1.0f + scn.v[j]) + shn.v[j];
                st_q8(H8 + (size_t)row * D, SR + row, F.lane, x); }
        }
    }
}

__device__ __forceinline__ void moe_gather(Frame& F) {
    const int gw = F.vcu * NWAVES + F.wave, NGW = F.G * NWAVES; const int ntiles = ((const int*)(F.ws + WS_MOE + MOE_META))[0];
    const int* rtok = (const int*)(F.ws + WS_MOE + MOE_ROWTOK); const signed char* H8 = (const signed char*)(F.ws + WS_H); signed char* AS = (signed char*)(F.ws + WS_ASORT);
    const float* SR = (const float*)(F.ws + WS_SROW); float* SS = (float*)(F.ws + WS_SSORT);
    const int np = min(max(ntiles, 0), MOE_MAXT) * 256;
    for (int pos = gw; pos < np; pos += 4 * NGW) {
        int tok[4]; u32x4 a[4]; float sc[4];
#pragma unroll
        for (int q = 0; q < 4; ++q) { const int p = pos + q * NGW; tok[q] = p < np ? min(max(rtok[p], 0), TL - 1) : 0; }
#pragma unroll
        for (int q = 0; q < 4; ++q) { a[q] = *(const u32x4*)(H8 + (size_t)tok[q] * D + 16 * F.lane); sc[q] = SR[tok[q]]; }
#pragma unroll
        for (int q = 0; q < 4; ++q) { const int p = pos + q * NGW; if (p < np) { *(u32x4*)(AS + (size_t)p * D + 16 * F.lane) = a[q]; if (F.lane == 0) SS[p] = sc[q]; } } }
}

constexpr int GP = 144;
constexpr int G_VS = 0, G_QT = 9216, G_QH = 18432, G_KT = 27648, G_KH = 36864, G_AM = 46080, G_B = 55296, G_LR = 71680, G_TOT = 75776, G_ROPE = 77824, G_OB = 86016;
__device__ __forceinline__ bf16x8 cat8(s16x4 a, s16x4 b) { return __builtin_shufflevector(a, b, 0, 1, 2, 3, 4, 5, 6, 7); }
__device__ __forceinline__ bf16x8 pack8(f32x4 a, f32x4 b) { u32x4 p; p.x = pk2(a[0], a[1]); p.y = pk2(a[2], a[3]); p.z = pk2(b[0], b[1]); p.w = pk2(b[2], b[3]); return __builtin_bit_cast(bf16x8, p); }
__device__ __forceinline__ void gla_phase(Frame& F, int layer) {
    const bf16* proj = (const bf16*)(F.ws + WS_BIG); bf16* Obuf = (bf16*)(F.ws + WS_O); const float* rope = (const float*)(F.ws + WS_ROPE);
    LAS unsigned char* L = F.lds;
    const int t = F.tid, lane = F.lane, w = F.wave, g = lane >> 4, l15 = lane & 15, r4 = l15 >> 2, c4 = l15 & 3;
    LAS float* LB = (LAS float*)(L + G_B); LAS float* TOT = (LAS float*)(L + G_TOT);
    for (int u = F.vcu; u < 256; u += F.G) {
        const int b = u >> 4, h = (u >> 2) & 3, dir = (u >> 1) & 1, vh = u & 1;
        const int gtd = w & 3, gtsh = w >> 2;
        bf16x8 wgf;
        { const float* WG = F.inp(I_GWG) + ((size_t)(layer * 2 + dir) * 16 + 8 * (g & 1)) * 256 + 64 * h + 16 * gtd + l15;
          float wv[8];
#pragma unroll
          for (int j = 0; j < 8; ++j) wv[j] = g < 2 ? WG[j * 256] : 0.f;
          u32x4 pk; pk.x = pk2(wv[0], wv[1]); pk.y = pk2(wv[2], wv[3]); pk.z = pk2(wv[4], wv[5]); pk.w = pk2(wv[6], wv[7]); wgf = __builtin_bit_cast(bf16x8, pk); }
        const float bg = F.inp(I_GBG)[(layer * 2 + dir) * 256 + 64 * h + 16 * gtd + l15];
        bf16x8 cumA0, cumA1;
        { unsigned m[4];
#pragma unroll
          for (int j = 0; j < 4; ++j) m[j] = (4 * g + j <= l15) ? 0x3F80u : 0u;
          const u32x4 a0 = {m[0] | (m[1] << 16), m[2] | (m[3] << 16), 0u, 0u}, a1 = {0x3F803F80u, 0x3F803F80u, m[0] | (m[1] << 16), m[2] | (m[3] << 16)};
          cumA0 = __builtin_bit_cast(bf16x8, a0); cumA1 = __builtin_bit_cast(bf16x8, a1); }
        f32x4 S[4];
#pragma unroll
        for (int i = 0; i < 4; ++i) S[i] = (f32x4){0.f, 0.f, 0.f, 0.f};
        const int tensor = t >> 8, s = (t & 255) >> 2, p = t & 3, d0 = (p & 1) * 8 + (p >> 1) * 32;
        const int spos = dir ? 63 - s : s;
        const int sv = t >> 3, c8 = t & 7, svpos = dir ? 63 - sv : sv;
        const int sl = (t & 127) >> 1, hf = t & 1, slpos = dir ? 63 - sl : sl;
#define GLA_ROWBASE(ci_) ((ci_) < 4 ? TL + b * 256 + 64 * (dir ? 3 - (ci_) : (ci_)) : b * 4096 + 64 * (dir ? 63 - ((ci_) - 4) : ((ci_) - 4)))
        u32x4 c1n, c2n, vvn, lvn;
        { const int rb0 = GLA_ROWBASE(0); const bf16* src = proj + (size_t)(rb0 + spos) * PP + tensor * 256 + 64 * h + d0; c1n = *(const u32x4*)src; c2n = *(const u32x4*)(src + 16);
          vvn = *(const u32x4*)(proj + (size_t)(rb0 + svpos) * PP + C_GV + 128 * h + 64 * vh + 8 * c8);
          lvn = *(const u32x4*)(proj + (size_t)(rb0 + slpos) * PP + C_LR + 16 * dir + 8 * hf); }
        for (int i = t; i < 2048; i += 512) ((LAS float*)(L + G_ROPE))[i] = rope[i];
        int prev_rowbase = 0;
        for (int ci = 0; ci < 68; ++ci) {
            const int rowbase = GLA_ROWBASE(ci), rope_on = ci >= 4, rowpos = dir ? 63 - (ci - 4) : (ci - 4);
            const u32x4 c1 = c1n, c2 = c2n;
            *(LAS u32x4*)(L + G_VS + sv * GP + c8 * 16) = vvn;
            if (t < 128) *(LAS u32x4*)(L + G_LR + sl * 32 + hf * 16) = lvn;
            if (ci > 0) { const u32x4 ov = *(const LAS u32x4*)(L + G_OB + sv * GP + c8 * 16);
                *(u32x4*)(Obuf + (size_t)dir * TT * 512 + (size_t)(prev_rowbase + svpos) * 512 + 128 * h + 64 * vh + 8 * c8) = ov; }
            prev_rowbase = rowbase;
            if (ci + 1 < 68) { const int rb1 = GLA_ROWBASE(ci + 1); const bf16* src = proj + (size_t)(rb1 + spos) * PP + tensor * 256 + 64 * h + d0; c1n = *(const u32x4*)src; c2n = *(const u32x4*)(src + 16);
              vvn = *(const u32x4*)(proj + (size_t)(rb1 + svpos) * PP + C_GV + 128 * h + 64 * vh + 8 * c8);
              lvn = *(const u32x4*)(proj + (size_t)(rb1 + slpos) * PP + C_LR + 16 * dir + 8 * hf); }
            __syncthreads();
            f32x4 bl[2];
            { f32x4 gt[2];
#pragma unroll
              for (int i = 0; i < 2; ++i) { const bf16x8 af = *(const LAS bf16x8*)(L + G_LR + (16 * (2 * gtsh + i) + l15) * 32 + (g & 1) * 16);
                  f32x4 z = mfma16(af, wgf, (f32x4){0.f, 0.f, 0.f, 0.f});
#pragma unroll
                  for (int r = 0; r < 4; ++r) { const float zz = z[r] + bg; z[r] = (fminf(zz, 0.f) - __logf(1.0f + __expf(-fabsf(zz)))) * (1.0f / 16.0f); }
                  gt[i] = z; }
              const bf16x8 gB = pack8(gt[0], gt[1]);
              bl[0] = mfma16(cumA0, gB, (f32x4){0.f, 0.f, 0.f, 0.f}); bl[1] = mfma16(cumA1, gB, (f32x4){0.f, 0.f, 0.f, 0.f}); }
            if (gtsh == 0 && g == 3) TOT[16 * gtd + l15] = bl[1][3];
            __syncthreads();
            { const float off = gtsh ? TOT[16 * gtd + l15] : 0.f;
#pragma unroll
              for (int i = 0; i < 2; ++i)
#pragma unroll
                  for (int r = 0; r < 4; ++r) LB[(32 * gtsh + 16 * i + 4 * g + r) * 64 + 16 * gtd + l15] = bl[i][r] + off; }
            __syncthreads();
            { float x1[8], x2[8];
              x1[0] = bflo(c1.x); x1[1] = bfhi(c1.x); x1[2] = bflo(c1.y); x1[3] = bfhi(c1.y); x1[4] = bflo(c1.z); x1[5] = bfhi(c1.z); x1[6] = bflo(c1.w); x1[7] = bfhi(c1.w);
              x2[0] = bflo(c2.x); x2[1] = bfhi(c2.x); x2[2] = bflo(c2.y); x2[3] = bfhi(c2.y); x2[4] = bflo(c2.z); x2[5] = bfhi(c2.z); x2[6] = bflo(c2.w); x2[7] = bfhi(c2.w);
              if (rope_on) { const int pos = (p >> 1) ? spos : rowpos; const LAS float* rt = (const LAS float*)(L + G_ROPE) + (pos * 16 + (p & 1) * 8) * 2;
#pragma unroll
                  for (int jj = 0; jj < 8; ++jj) { const float cs = rt[2 * jj], sn = rt[2 * jj + 1]; const float a = x1[jj], bq = x2[jj]; x1[jj] = a * cs - bq * sn; x2[jj] = a * sn + bq * cs; } }
              const LAS float* Bs = LB + s * 64; const LAS float* Bref = LB + 32 * 64;
              float t1[8], t2[8];
              const float sgn = tensor ? -1.0f : 1.0f, sc0 = tensor ? 1.0f : 0.125f;
#pragma unroll
              for (int jj = 0; jj < 8; ++jj) { const float eA = (Bs[d0 + jj] - Bref[d0 + jj]) * sgn, eB = (Bs[d0 + 16 + jj] - Bref[d0 + 16 + jj]) * sgn;
                  t1[jj] = x1[jj] * sc0 * __expf(eA); t2[jj] = x2[jj] * sc0 * __expf(eB); }
              LAS unsigned char* pt = L + (tensor ? G_KT : G_QT) + s * GP + d0 * 2;
              *(LAS u32x4*)pt = (u32x4){pk2(t1[0], t1[1]), pk2(t1[2], t1[3]), pk2(t1[4], t1[5]), pk2(t1[6], t1[7])};
              *(LAS u32x4*)(pt + 32) = (u32x4){pk2(t2[0], t2[1]), pk2(t2[2], t2[3]), pk2(t2[4], t2[5]), pk2(t2[6], t2[7])}; }
            if (t < 192) { const int j = t >> 6, d = t & 63; const float br = LB[32 * 64 + d], bt = LB[63 * 64 + d];
                ((LAS float*)(L + G_QH))[t] = __expf(j == 0 ? br : (j == 1 ? bt - br : bt)); }
            __syncthreads();
#pragma unroll
            for (int i = 0; i < 2; ++i) { const int id = 2 * w + i, ts = id >> 2, tc = id & 3;
                f32x4 a = (f32x4){0.f, 0.f, 0.f, 0.f};
                if (ts <= tc) {
#pragma unroll
                    for (int ks = 0; ks < 2; ++ks) { const bf16x8 kf = *(const LAS bf16x8*)(L + G_KT + (16 * ts + l15) * GP + (8 * g + 32 * ks) * 2);
                        const bf16x8 qf = *(const LAS bf16x8*)(L + G_QT + (16 * tc + l15) * GP + (8 * g + 32 * ks) * 2); a = mfma16(kf, qf, a); } }
                const int c = 16 * tc + l15;
#pragma unroll
                for (int r = 0; r < 4; ++r) a[r] = (16 * ts + 4 * g + r <= c) ? a[r] : 0.f;
                u32x2 wv; wv.x = pk2(a[0], a[1]); wv.y = pk2(a[2], a[3]);
                *(LAS u32x2*)(L + G_AM + c * GP + (16 * ts + 4 * g) * 2) = wv; }
            __syncthreads();
            { const int vt = w & 3, chh = w >> 2; const LAS float* COL = (const LAS float*)(L + G_QH);
              bf16x8 Vf[2], Sb[2];
#pragma unroll
              for (int ks = 0; ks < 2; ++ks) { const LAS unsigned char* pa = L + G_VS + (32 * ks + 8 * g + r4) * GP + (16 * vt + 4 * c4) * 2;
                  Vf[ks] = cat8(tr_read(pa), tr_read(pa + 4 * GP));
                  const f32x4 c0 = *(const LAS f32x4*)(COL + 32 * ks + 4 * g), c1 = *(const LAS f32x4*)(COL + 32 * ks + 16 + 4 * g);
                  Sb[ks] = pack8(S[2 * ks] * c0, S[2 * ks + 1] * c1); }
#pragma unroll
              for (int i = 0; i < 2; ++i) { const int tc = 2 * chh + i, c = 16 * tc + l15;
                  f32x4 o = (f32x4){0.f, 0.f, 0.f, 0.f};
#pragma unroll
                  for (int ks = 0; ks < 2; ++ks) { const u32x2 q0 = *(const LAS u32x2*)(L + G_QT + c * GP + (32 * ks + 4 * g) * 2), q1 = *(const LAS u32x2*)(L + G_QT + c * GP + (32 * ks + 16 + 4 * g) * 2);
                      o = mfma16(__builtin_bit_cast(bf16x8, ((u32x4){q0.x, q0.y, q1.x, q1.y})), Sb[ks], o); }
#pragma unroll
                  for (int ks = 0; ks < 2; ++ks) if (32 * ks <= 16 * tc + 15) { const bf16x8 am = *(const LAS bf16x8*)(L + G_AM + c * GP + (32 * ks + 8 * g) * 2); o = mfma16(am, Vf[ks], o); }
#pragma unroll
                  for (int r = 0; r < 4; ++r) *(LAS bf16*)(L + G_OB + (16 * tc + 4 * g + r) * GP + (16 * vt + l15) * 2) = (bf16)f2bf(o[r]); }
#pragma unroll
              for (int dt = 0; dt < 4; ++dt) { f32x4 T = (f32x4){0.f, 0.f, 0.f, 0.f};
#pragma unroll
                  for (int ks = 0; ks < 2; ++ks) { const LAS unsigned char* pa = L + G_KT + (32 * ks + 8 * g + r4) * GP + (16 * dt + 4 * c4) * 2;
                      T = mfma16(cat8(tr_read(pa), tr_read(pa + 4 * GP)), Vf[ks], T); }
                  const f32x4 ck = *(const LAS f32x4*)(COL + 64 + 16 * dt + 4 * g), dc = *(const LAS f32x4*)(COL + 128 + 16 * dt + 4 * g);
                  S[dt] = S[dt] * dc + T * ck; } }
            __syncthreads();
        }
        { const u32x4 ov = *(const LAS u32x4*)(L + G_OB + sv * GP + c8 * 16);
          *(u32x4*)(Obuf + (size_t)dir * TT * 512 + (size_t)(prev_rowbase + svpos) * 512 + 128 * h + 64 * vh + 8 * c8) = ov; }
        __syncthreads();
#undef GLA_ROWBASE
    }
}
__device__ __forceinline__ void gla_combine(Frame& F, int layer) {
    const int gw = F.vcu * NWAVES + F.wave; const bf16* proj = (const bf16*)(F.ws + WS_BIG); const bf16* Of = (const bf16*)(F.ws + WS_O); const bf16* Ob = Of + (size_t)TT * 512;
    bf16* Hc = (bf16*)(F.ws + WS_H);
    float gn[8];
#pragma unroll
    for (int i = 0; i < 8; ++i) gn[i] = F.inp(I_GGN)[layer * 128 + ((8 * F.lane) & 127) + i];
    const int nseg = layer == 0 ? 2 : 1;
    for (int seg = 0; seg < nseg; ++seg) { const int r0 = seg ? TL + 2 * gw : 32 * gw, nr = seg ? 2 : 32;
        u32x4 an = *(const u32x4*)(Of + (size_t)r0 * 512 + 8 * F.lane), bn = *(const u32x4*)(Ob + (size_t)r0 * 512 + 8 * F.lane), rn = *(const u32x4*)(proj + (size_t)r0 * PP + C_GR + 8 * F.lane);
        for (int i = 0; i < nr; ++i) { const int row = r0 + i;
            const u32x4 a = an, b = bn, r = rn;
            if (i + 1 < nr) { an = *(const u32x4*)(Of + (size_t)(row + 1) * 512 + 8 * F.lane); bn = *(const u32x4*)(Ob + (size_t)(row + 1) * 512 + 8 * F.lane); rn = *(const u32x4*)(proj + (size_t)(row + 1) * PP + C_GR + 8 * F.lane); }
            float o[8], rr[8];
            o[0] = bflo(a.x) + bflo(b.x); o[1] = bfhi(a.x) + bfhi(b.x); o[2] = bflo(a.y) + bflo(b.y); o[3] = bfhi(a.y) + bfhi(b.y); o[4] = bflo(a.z) + bflo(b.z); o[5] = bfhi(a.z) + bfhi(b.z); o[6] = bflo(a.w) + bflo(b.w); o[7] = bfhi(a.w) + bfhi(b.w);
            rr[0] = bflo(r.x); rr[1] = bfhi(r.x); rr[2] = bflo(r.y); rr[3] = bfhi(r.y); rr[4] = bflo(r.z); rr[5] = bfhi(r.z); rr[6] = bflo(r.w); rr[7] = bfhi(r.w);
            float ss = 0.f;
#pragma unroll
            for (int q = 0; q < 8; ++q) ss += o[q] * o[q];
            ss = red_row16<OpAdd>(ss);
            const float ri = 1.0f / sqrtf(ss * (1.0f / 128.0f) + EPS);
            float v[8];
#pragma unroll
            for (int q = 0; q < 8; ++q) v[q] = (o[q] * ri * gn[q]) * (rr[q] / (1.0f + __expf(-rr[q])));
            *(u32x4*)(Hc + (size_t)row * D + 8 * F.lane) = (u32x4){pk2(v[0], v[1]), pk2(v[2], v[3]), pk2(v[4], v[5]), pk2(v[6], v[7])}; } }
}

constexpr int NA_CK = 0, NA_CV = 36864;
constexpr int NA_RK = 0, NA_RV = 63360, NA_RPB = 126720;
constexpr float NA_SC = 0.125f * 1.44269504f;
struct NaSt { float m, l; f32x4 OT[4]; };
__device__ __forceinline__ int na_sw(int row, int c) { return row * 144 + (c << 4); }
__device__ __forceinline__ void na_softmax(NaSt& st, f32x4 (&s)[4], bf16x8 (&pf)[2]) {
    float mx = fmaxf(fmaxf(fmaxf(s[0][0], s[0][1]), fmaxf(s[0][2], s[0][3])), fmaxf(fmaxf(s[1][0], s[1][1]), fmaxf(s[1][2], s[1][3])));
    mx = fmaxf(mx, fmaxf(fmaxf(fmaxf(s[2][0], s[2][1]), fmaxf(s[2][2], s[2][3])), fmaxf(fmaxf(s[3][0], s[3][1]), fmaxf(s[3][2], s[3][3]))));
    mx = red_x32<OpMax>(red_x16<OpMax>(mx));
    const float mnew = fmaxf(st.m, mx), alpha = __builtin_amdgcn_exp2f(st.m - mnew);
    float ps = 0.f;
#pragma unroll
    for (int i = 0; i < 4; ++i)
#pragma unroll
        for (int r = 0; r < 4; ++r) { const float pv = __builtin_amdgcn_exp2f(s[i][r] - mnew); s[i][r] = pv; ps += pv; }
    st.l = st.l * alpha + ps; st.m = mnew;
#pragma unroll
    for (int dt = 0; dt < 4; ++dt) st.OT[dt] *= alpha;
    pf[0] = pack8(s[0], s[1]); pf[1] = pack8(s[2], s[3]);
}
__device__ __forceinline__ void na_ctx_chunks(NaSt& st, const LAS unsigned char* L, int g, int l15, int r4, int c4, const bf16x8 (&qf)[2]) {
#pragma unroll 1
    for (int cc = 0; cc < 4; ++cc) {
        f32x4 s[4]; bf16x8 pf[2];
#pragma unroll
        for (int i = 0; i < 4; ++i) { const int key = 16 * (4 * cc + i) + l15;
            const bf16x8 k0 = *(const LAS bf16x8*)(L + NA_CK + na_sw(key, g)), k1 = *(const LAS bf16x8*)(L + NA_CK + na_sw(key, g + 4));
            f32x4 a = mfma16(k0, qf[0], (f32x4){0.f, 0.f, 0.f, 0.f}); a = mfma16(k1, qf[1], a); s[i] = a * NA_SC; }
        na_softmax(st, s, pf);
#pragma unroll
        for (int kk = 0; kk < 2; ++kk) { const int key = 16 * (4 * cc + 2 * kk) + 4 * g + r4;
#pragma unroll
            for (int dt = 0; dt < 4; ++dt) {
                const LAS unsigned char* pa = L + NA_CV + na_sw(key, 2 * dt + (c4 >> 1)) + (c4 & 1) * 8;
                const LAS unsigned char* pb = L + NA_CV + na_sw(key + 16, 2 * dt + (c4 >> 1)) + (c4 & 1) * 8;
                st.OT[dt] = mfma16(cat8(tr_read(pa), tr_read(pb)), pf[kk], st.OT[dt]); } }
    }
}
__device__ __forceinline__ void na_finish(NaSt& st, bf16* dst  , int g) {
    float l = red_x32<OpAdd>(red_x16<OpAdd>(st.l));
    const float inv = 1.0f / l;
#pragma unroll
    for (int dt = 0; dt < 4; ++dt) { u32x2 wv; wv.x = pk2(st.OT[dt][0] * inv, st.OT[dt][1] * inv); wv.y = pk2(st.OT[dt][2] * inv, st.OT[dt][3] * inv); *(u32x2*)(dst + 16 * dt + 4 * g) = wv; }
}
__device__ __forceinline__ void na_phase(Frame& F, int layer) {
    const bf16* proj = (const bf16*)(F.ws + WS_BIG); bf16* Hc = (bf16*)(F.ws + WS_H);
    LAS unsigned char* L = F.lds; LAS float* RPB = (LAS float*)(L + NA_RPB);
    const int t = F.tid, lane = F.lane, w = F.wave, g = lane >> 4, l15 = lane & 15, r4 = l15 >> 2, c4 = l15 & 3;
    for (int task = F.vcu; task < 256; task += F.G) {
        const int ch = task & 1, h = (task >> 1) & 7, b = task >> 4, kc0 = ch ? 24 : 0;
        const int jb = 2 * ch + (w & 1), c = 16 * jb + l15;
        unsigned* part = (unsigned*)(F.ws + WS_NAPART) + (size_t)task * 128 * 640;
        const bf16* qbase = proj + (size_t)(b * 4096 + c) * PP + C_NQ + 64 * h + 8 * g;
        for (int q = t; q < 4096; q += 512) { const int tensor = q >> 11, key = (q >> 3) & 255, cc8 = q & 7;
            const u32x4 v = *(const u32x4*)(proj + (size_t)(TL + b * 256 + key) * PP + (tensor ? C_NV : C_NK) + 64 * h + 8 * cc8);
            *(LAS u32x4*)(L + (tensor ? NA_CV : NA_CK) + na_sw(key, cc8)) = v; }
        __syncthreads();
        if (layer == 0) {
            const int tok = TL + b * 256 + 128 * ch + 16 * w + l15;
            bf16x8 qf[2];
            { const bf16* qp = proj + (size_t)tok * PP + C_NQ + 64 * h + 8 * g; qf[0] = *(const bf16x8*)qp; qf[1] = *(const bf16x8*)(qp + 32); }
            NaSt st; st.m = -1.0e30f; st.l = 0.f;
#pragma unroll
            for (int dt = 0; dt < 4; ++dt) st.OT[dt] = (f32x4){0.f, 0.f, 0.f, 0.f};
            na_ctx_chunks(st, L, g, l15, r4, c4, qf);
            na_finish(st, Hc + (size_t)tok * D + 512 + 64 * h, g);
        }
        {
            bf16x8 qn[2];
            { const bf16* qp = qbase + (size_t)((w >> 1) * 64) * PP; qn[0] = *(const bf16x8*)qp; qn[1] = *(const bf16x8*)(qp + 32); }
#pragma unroll 1
            for (int i = 0; i < 16; ++i) {
                bf16x8 qf[2]; qf[0] = qn[0]; qf[1] = qn[1];
                if (i + 1 < 16) { const bf16* qp = qbase + (size_t)((4 * (i + 1) + (w >> 1)) * 64) * PP; qn[0] = *(const bf16x8*)qp; qn[1] = *(const bf16x8*)(qp + 32); }
                NaSt st; st.m = -1.0e30f; st.l = 0.f;
#pragma unroll
                for (int dt = 0; dt < 4; ++dt) st.OT[dt] = (f32x4){0.f, 0.f, 0.f, 0.f};
                na_ctx_chunks(st, L, g, l15, r4, c4, qf);
                unsigned* pr = part + (size_t)(8 * i + w) * 640 + lane;
                pr[0] = __builtin_bit_cast(unsigned, st.m); pr[64] = __builtin_bit_cast(unsigned, st.l);
#pragma unroll
                for (int dt = 0; dt < 4; ++dt) { pr[64 * (2 + 2 * dt)] = pk2(st.OT[dt][0], st.OT[dt][1]); pr[64 * (3 + 2 * dt)] = pk2(st.OT[dt][2], st.OT[dt][3]); }
            }
        }
        __syncthreads();
        for (int q = t; q < 8 * 640; q += 512) { const int row = q / 640, rem = q - row * 640, tensor = rem / 320, r2 = rem - tensor * 320, key = r2 >> 3, cc8 = r2 & 7;
            const u32x4 v = *(const u32x4*)(proj + (size_t)(b * 4096 + row * 64 + kc0 + key) * PP + (tensor ? C_NV : C_NK) + 64 * h + 8 * cc8);
            *(LAS u32x4*)(L + (tensor ? NA_RV : NA_RK) + na_sw((row % 11) * 40 + key, cc8)) = v; }
        for (int i = t; i < 465; i += 512) RPB[i] = F.inp(I_RPB)[(size_t)(layer * 8 + h) * 465 + i] * 1.44269504f;
        int have = 7;
        __syncthreads();
        const int kl0 = (jb & 1) ? 8 : 0, lo = kc0 + kl0, cs = min(max(c - 8, 0), 48);
        bf16x8 qn[2]; unsigned pn[10];
        { const bf16* qp = qbase + (size_t)((w >> 1) * 64) * PP; qn[0] = *(const bf16x8*)qp; qn[1] = *(const bf16x8*)(qp + 32);
          const unsigned* pr = part + (size_t)w * 640 + lane;
#pragma unroll
          for (int j = 0; j < 10; ++j) pn[j] = pr[64 * j]; }
#pragma unroll 1
        for (int st_ = 0; st_ < 16; ++st_) {
            const int qrow = 4 * st_ + (w >> 1), tok = b * 4096 + qrow * 64 + c;
            bf16x8 qf[2]; qf[0] = qn[0]; qf[1] = qn[1];
            NaSt st; st.m = __builtin_bit_cast(float, pn[0]); st.l = __builtin_bit_cast(float, pn[1]);
#pragma unroll
            for (int dt = 0; dt < 4; ++dt) st.OT[dt] = (f32x4){bflo(pn[2 + 2 * dt]), bfhi(pn[2 + 2 * dt]), bflo(pn[3 + 2 * dt]), bfhi(pn[3 + 2 * dt])};
            u32x4 pre[5]; int nnew = 0;
            if (st_ + 1 < 16) {
                const int hin = min(max(4 * (st_ + 1) - 1, 0), 56) + 7; nnew = hin - have;
#pragma unroll
                for (int j = 0; j < 5; ++j) { const int q = t + 512 * j;
                    if (q < nnew * 640) { const int ri = q / 640, rem = q - ri * 640, tensor = rem / 320, r2 = rem - tensor * 320, key = r2 >> 3, cc8 = r2 & 7;
                        pre[j] = *(const u32x4*)(proj + (size_t)(b * 4096 + (have + 1 + ri) * 64 + kc0 + key) * PP + (tensor ? C_NV : C_NK) + 64 * h + 8 * cc8); } }
                const bf16* qp = qbase + (size_t)((qrow + 4) * 64) * PP; qn[0] = *(const bf16x8*)qp; qn[1] = *(const bf16x8*)(qp + 32);
                const unsigned* pr = part + (size_t)(8 * (st_ + 1) + w) * 640 + lane;
#pragma unroll
                for (int j = 0; j < 10; ++j) pn[j] = pr[64 * j];
            }
            const int rs = min(max(qrow - 4, 0), 56);
#pragma unroll 1
            for (int lc = 0; lc < 4; ++lc) {
                f32x4 s[4]; bf16x8 pf[2];
#pragma unroll
                for (int kk = 0; kk < 2; ++kk) { const int i = 2 * lc + kk, slot = (rs + i) % 11, roff = rs + i - qrow + 7;
#pragma unroll
                    for (int hf = 0; hf < 2; ++hf) { const int kidx = slot * 40 + kl0 + 16 * hf + l15;
                        const bf16x8 k0 = *(const LAS bf16x8*)(L + NA_RK + na_sw(kidx, g)), k1 = *(const LAS bf16x8*)(L + NA_RK + na_sw(kidx, g + 4));
                        f32x4 a = mfma16(k0, qf[0], (f32x4){0.f, 0.f, 0.f, 0.f}); a = mfma16(k1, qf[1], a);
#pragma unroll
                        for (int r = 0; r < 4; ++r) { const int kc = lo + 16 * hf + 4 * g + r; const bool valid = (kc >= cs) && (kc < cs + 16);
                            const int coff = min(max(kc - c + 15, 0), 30);
                            a[r] = valid ? a[r] * NA_SC + RPB[roff * 31 + coff] : -1.0e30f; }
                        s[2 * kk + hf] = a; } }
                na_softmax(st, s, pf);
#pragma unroll
                for (int kk = 0; kk < 2; ++kk) { const int slot = (rs + 2 * lc + kk) % 11, kidx = slot * 40 + kl0 + 4 * g + r4;
#pragma unroll
                    for (int dt = 0; dt < 4; ++dt) {
                        const LAS unsigned char* pa = L + NA_RV + na_sw(kidx, 2 * dt + (c4 >> 1)) + (c4 & 1) * 8;
                        const LAS unsigned char* pb = L + NA_RV + na_sw(kidx + 16, 2 * dt + (c4 >> 1)) + (c4 & 1) * 8;
                        st.OT[dt] = mfma16(cat8(tr_read(pa), tr_read(pb)), pf[kk], st.OT[dt]); } }
            }
            na_finish(st, Hc + (size_t)tok * D + 512 + 64 * h, g);
            __syncthreads();
            if (nnew > 0) {
#pragma unroll
                for (int j = 0; j < 5; ++j) { const int q = t + 512 * j;
                    if (q < nnew * 640) { const int ri = q / 640, rem = q - ri * 640, tensor = rem / 320, r2 = rem - tensor * 320, key = r2 >> 3, cc8 = r2 & 7;
                        *(LAS u32x4*)(L + (tensor ? NA_RV : NA_RK) + na_sw(((have + 1 + ri) % 11) * 40 + key, cc8)) = pre[j]; } }
                have += nnew;
            }
            __syncthreads();
        }
    }
}


#ifndef REP_P0
#define REP_P0 1
#endif
#ifndef REP_GLA
#define REP_GLA 1
#endif
#ifndef REP_NA
#define REP_NA 1
#endif
#ifndef REP_GEMM
#define REP_GEMM 1
#endif
#ifdef NO_P0
#define PH_P0(x)
#else
#define PH_P0(x) for (int rep_ = 0; rep_ < REP_P0; ++rep_) { x __syncthreads(); }
#endif
#ifdef NO_T
#define PH_T(x)
#else
#define PH_T(x) x
#endif
#ifdef NO_T2
#define PH_T2(x)
#else
#define PH_T2(x) x
#endif
#ifdef NO_GLA
#define PH_GLA(x)
#else
#define PH_GLA(x) for (int rep_ = 0; rep_ < REP_GLA; ++rep_) { x }
#endif
#ifdef NO_NA
#define PH_NA(x)
#else
#define PH_NA(x) for (int rep_ = 0; rep_ < REP_NA; ++rep_) { x }
#endif
#ifdef NO_GEMM
#define PH_GEMM if (0)
#else
#define PH_GEMM _Pragma("unroll 1") for (int rep_ = 0; rep_ < REP_GEMM; ++rep_)
#endif
#define IN(k) (lo <= (k) && (k) < hi)
#define SEAM(k) do { if (IN(k) && IN((k) + 1)) xcd_barrier(bar); } while (0)
template <int L> __device__ __forceinline__ void layer_phases(Frame& F, const XcdBarrier& bar, const int lo, const int hi) {
    constexpr int l = L; constexpr int pb = 2 + 8 * l;
    bf16* Hb = (bf16*)(F.ws + WS_H); bf16* BIG = (bf16*)(F.ws + WS_BIG);
        if (IN(pb + 0)) { pg8::Gemm g{Hb, (const bf16*)(F.ws + WS_WIN + (size_t)l * PP * D), TT, PP, D / 2, nullptr, 0}; pg8::StaticOrder S; S.init(TT, PP, F.G, (int)blockIdx.x);
            pg8::EpiBf16Q E{BIG, PP, (const float*)(F.ws + WS_SROW), (const float*)(F.ws + WS_SB_IN) + (size_t)l * PP, nullptr, 0, 0.f};
            PH_GEMM pg8::gemm_phase<pg8::EpiBf16Q, pg8::StaticOrder, true, false, 1>(F.lds + RING_OFF, g, S, E); }
        SEAM(pb + 0);
        if (IN(pb + 1)) { PH_GLA(gla_phase(F, l);) }
        SEAM(pb + 1);
        if (IN(pb + 2)) { PH_T(gla_combine(F, l);) PH_NA(na_phase(F, l);) }
        SEAM(pb + 2);
        if (IN(pb + 3)) { const int M = l == 0 ? TT : TL; pg8::Gemm g{Hb, (const bf16*)(F.ws + WS_WOUT) + (size_t)l * D * D, M, D, D, nullptr, 0}; pg8::StaticOrder S; S.init(M, D, F.G, (int)blockIdx.x);
            pg8::EpiBf16 E{BIG, D};
            PH_GEMM pg8::gemm_phase<pg8::EpiBf16, pg8::StaticOrder, true, false>(F.lds + RING_OFF, g, S, E); }
        SEAM(pb + 3);
        if (IN(pb + 4)) { PH_T2(t2_postmix(F, l);) }
        SEAM(pb + 4);
        if constexpr (l == 0) {
            if (IN(7)) { pg8::Gemm g{Hb, (const bf16*)(F.ws + WS_WGU0), TT, 2 * DFF, D / 2, nullptr, 0}; pg8::StaticOrder S; S.init(TT, 2 * DFF, F.G, (int)blockIdx.x);
                pg8::EpiSwiGLUQ8 E{(signed char*)BIG, DFF, (const float*)(F.ws + WS_SROW), (const float*)(F.ws + WS_SB_GU0), nullptr, 0, 127.0f / HID_RANGE};
                PH_GEMM pg8::gemm_phase<pg8::EpiSwiGLUQ8, pg8::StaticOrder, true, false, 1>(F.lds + RING_OFF, g, S, E); }
            SEAM(7);
            if (IN(8)) { pg8::Gemm g{BIG, (const bf16*)(F.ws + WS_WD0), TT, D, DFF / 2, nullptr, 0}; pg8::StaticOrder S; S.init(TT, D, F.G, (int)blockIdx.x);
                pg8::EpiBf16Q E{(bf16*)(F.ws + WS_O), D, nullptr, (const float*)(F.ws + WS_SB_D0), nullptr, 0, HID_RANGE / 127.0f};
                PH_GEMM pg8::gemm_phase<pg8::EpiBf16Q, pg8::StaticOrder, true, false, 1>(F.lds + RING_OFF, g, S, E); }
            SEAM(8);
            if (IN(9)) { PH_T(t3_postffn(F, 0);) }
            SEAM(9);
        }
    }
struct Args { const float* in[23]; float* out; unsigned char* ws; int ph_lo, ph_hi, li, pad; };
constexpr int NPHASE = 24;
__global__ void __launch_bounds__(NWAVES * 64, 2) fwd_kernel(Args args) {
    extern __shared__ __attribute__((aligned(16))) unsigned char lds[];
    Frame F;
    F.lds = (LAS unsigned char*)lds;
    F.tid = threadIdx.x; F.lane = F.tid & 63; F.wave = __builtin_amdgcn_readfirstlane(F.tid >> 6);
    F.G = gridDim.x; { const int bx = blockIdx.x; F.vcu = (F.G % 8 == 0) ? (bx % 8) * (F.G / 8) + bx / 8 : bx; }
    F.ws = args.ws; F.out = args.out;
    volatile LAS unsigned* MISC = (volatile LAS unsigned*)(F.lds + MISC_OFF);
    for (int u = F.tid; u < (LDS_BYTES - LDSCTL_OFF) / 4; u += NWAVES * 64) ((LAS unsigned*)(F.lds + LDSCTL_OFF))[u] = 0u;
    if (F.tid < 23) ((LAS unsigned long long*)(F.lds + PTAB_OFF))[F.tid] = (unsigned long long)args.in[F.tid];
    __syncthreads();
    unsigned* ctl = (unsigned*)(F.ws + WS_CTL);
    XcdBarrier bar = xcd_barrier_post(ctl + CW_BAR + args.li * XCD_BAR_WORDS, MISC + 8);
    const int lo = args.ph_lo, hi = args.ph_hi;

    if (IN(0)) { PH_P0(p0_prologue(F);) } SEAM(0);
    if (IN(1)) { PH_T(t1_prenorm(F);) } SEAM(1);

    layer_phases<0>(F, bar, lo, hi);
    layer_phases<1>(F, bar, lo, hi);
    if (IN(15)) { PH_T(m2_lists(F);) }
    SEAM(15);
    if (IN(16)) { PH_T(moe_gather(F);) }
    SEAM(16);
    for (int sl = 0; sl < MOE_NSL; ++sl) {
        const int pg = 17 + 2 * sl;
        if (IN(pg) || IN(pg + 1)) {
            const int ntiles = min(max(((const int*)(F.ws + WS_MOE + MOE_META))[0], 0), MOE_MAXT);
            const int t0 = sl * MOE_SLT, nts = min(max(ntiles - t0, 0), MOE_SLT);
            LAS int* texp = (LAS int*)(F.lds + IDX_OFF);
            if (nts > 0) { if (F.tid < MOE_SLT) texp[F.tid] = min(max(((const int*)(F.ws + WS_MOE + MOE_TEXP))[t0 + F.tid], 0), NE - 1); __syncthreads(); }
            if (IN(pg) && nts > 0) {
                pg8::StaticOrder S; S.init(nts * 256, 2 * DFE, F.G, (int)blockIdx.x);
                pg8::Gemm g{(const bf16*)(F.ws + WS_ASORT + (size_t)t0 * 256 * D), (const bf16*)(F.ws + WS_WGU1), nts * 256, 2 * DFE, D / 2, texp, (size_t)DFE * D};
                pg8::EpiSwiGLUQ8 E{(signed char*)(F.ws + WS_HIDS), DFE, (const float*)(F.ws + WS_SSORT) + (size_t)t0 * 256, (const float*)(F.ws + WS_SB_GU1), texp, 2 * DFE, 127.0f / HID_RANGE};
                PH_GEMM pg8::gemm_phase<pg8::EpiSwiGLUQ8, pg8::StaticOrder, true, true, 1>(F.lds + RING_OFF, g, S, E);
            }
            SEAM(pg);
            if (IN(pg + 1) && nts > 0) {
                pg8::StaticOrder S; S.init(nts * 256, D, F.G, (int)blockIdx.x);
                pg8::Gemm g{(const bf16*)(F.ws + WS_HIDS), (const bf16*)(F.ws + WS_WD1), nts * 256, D, DFE / 2, texp, (size_t)D * DFE / 2};
                pg8::EpiBf16Q E{(bf16*)(F.ws + WS_OUTP) + (size_t)t0 * 256 * D, D, nullptr, (const float*)(F.ws + WS_SB_D1), texp, D, HID_RANGE / 127.0f};
                PH_GEMM pg8::gemm_phase<pg8::EpiBf16Q, pg8::StaticOrder, true, true, 1>(F.lds + RING_OFF, g, S, E);
            }
            SEAM(pg + 1);
        } else { SEAM(pg); SEAM(pg + 1); }
    }
    if (IN(17 + 2 * MOE_NSL)) { PH_T(t3_postffn(F, 1);) }
}

#ifndef MK_LAUNCH_PER_PHASE
#define MK_LAUNCH_PER_PHASE 0
#endif
extern "C" void kernel_launch(void* const* d_in, const int* in_sizes, int n_in, void* d_out, int out_size, void* d_ws, size_t ws_size, hipStream_t stream) {
    static int grid = 0;
    if (grid == 0) {
        if (n_in != 23 || out_size != TL * D || ws_size < WS_END) { fprintf(stderr, "kernel_launch: unexpected shapes (n_in %d, out %d, ws %zu)\n", n_in, out_size, ws_size); grid = -1; return; }
        int dev = 0, cus = 0, per_cu = 0;
        if (hipGetDevice(&dev) != hipSuccess || hipDeviceGetAttribute(&cus, hipDeviceAttributeMultiprocessorCount, dev) != hipSuccess) { grid = -1; return; }
        if (hipFuncSetAttribute((const void*)fwd_kernel, hipFuncAttributeMaxDynamicSharedMemorySize, LDS_BYTES) != hipSuccess) { fprintf(stderr, "kernel_launch: hipFuncSetAttribute failed\n"); grid = -1; return; }
        if (hipOccupancyMaxActiveBlocksPerMultiprocessor(&per_cu, (const void*)fwd_kernel, NWAVES * 64, LDS_BYTES) != hipSuccess || per_cu < 1) fprintf(stderr, "kernel_launch: occupancy query reports %d\n", per_cu);
        (void)hipGetLastError();
        grid = 256;
        if (cus < 256) fprintf(stderr, "kernel_launch: device has %d CUs, this kernel needs 256\n", cus);
    }
    if (grid < 0) return;
    if (hipMemsetAsync((char*)d_ws + WS_CTL, 0, CTL_ZERO_BYTES, stream) != hipSuccess) return;
    Args a{};
    for (int i = 0; i < 23; ++i) a.in[i] = (const float*)d_in[i];
    a.out = (float*)d_out; a.ws = (unsigned char*)d_ws;
#if MK_LAUNCH_PER_PHASE
    for (int p = 0; p < NPHASE; ++p) { a.ph_lo = p; a.ph_hi = p + 1; a.li = 0; a.pad = 0;
        hipLaunchKernelGGL(fwd_kernel, dim3(grid), dim3(NWAVES * 64), LDS_BYTES, stream, a); }
#else
    a.ph_lo = 0; a.ph_hi = NPHASE; a.li = 0; a.pad = 0;
    hipLaunchKernelGGL(fwd_kernel, dim3(grid), dim3(NWAVES * 64), LDS_BYTES, stream, a);
#endif
}
```

```cpp
#include <hip/hip_runtime.h>
#include <cstdio>
#include <cstdint>

namespace pg8 {
#define PG8_LAS __attribute__((address_space(3)))
typedef unsigned short bf16_t;
typedef short bf16x8 __attribute__((ext_vector_type(8)));
typedef float f32x4 __attribute__((ext_vector_type(4)));
typedef unsigned u32x4 __attribute__((ext_vector_type(4)));
typedef unsigned u32x2 __attribute__((ext_vector_type(2)));
constexpr int BM = 256, BK = 64, HALF = 128, HTB = HALF * BK * 2, STAGE_BYTES = 8 * HTB, NXCD = 8, WGM = 8;

__host__ __device__ __forceinline__ int lds_byte(int r, int c) { const int st = (r >> 4) * 2 + (c >> 5), rr = r & 15, cc = c & 31, ob = rr * 64 + cc * 2; return st * 1024 + (ob ^ (((ob >> 9) & 1) << 5)); }
__host__ __device__ __forceinline__ void stage_rc(int b, int& R, int& C) { const int st = b / 1024, sb = b % 1024, swz = sb ^ (((sb >> 9) & 1) << 5); R = (st >> 1) * 16 + swz / 64; C = (st & 1) * 32 + (swz % 64) / 2; }
__host__ __device__ __forceinline__ int perm32(int rho) { const int n = rho >> 4, i = rho & 15; return 8 * (i >> 2) + 4 * n + (i & 3); }

struct Unit { int pm, pn; };
struct Gemm { const bf16_t* A; const bf16_t* Bt; int M, N, K; const PG8_LAS int* texp; size_t estride; };

struct StaticOrder {
    int nM, nN, nwg, G, c;
    __host__ __device__ void init(int M, int N, int G_, int c_) { nM = M / BM; nN = N / BM; nwg = nM * nN; G = G_; c = c_; }
    __host__ __device__ bool next(int i, Unit& u) const {
        const long L = (long)i * G + c; if (L >= nwg) return false;
        int wgid = (int)L; { const int q = nwg / NXCD, r = nwg % NXCD, xcd = wgid % NXCD, off = wgid / NXCD; wgid = (xcd < r ? xcd * (q + 1) : r * (q + 1) + (xcd - r) * q) + off; }
        const int nig = WGM * nN, gid = wgid / nig, fm = gid * WGM, gsz = (nM - fm) < WGM ? (nM - fm) : WGM;
        u.pm = fm + ((wgid % nig) % gsz); u.pn = (wgid % nig) / gsz; return true;
    }
};

__device__ __forceinline__ unsigned cvt_pk_bf16(float lo, float hi) { unsigned r; asm volatile("v_cvt_pk_bf16_f32 %0, %1, %2" : "=v"(r) : "v"(lo), "v"(hi)); return r; }

struct EpiBf16 {
    static constexpr bool PERM = true;
    bf16_t* O; int ldc;
    __device__ __forceinline__ void operator()(const f32x4 (&acc)[2][2][4][2], const Unit& u, int wr, int wc, int fr, int fq) const {
        const int row0 = u.pm * BM + wr * 64 + fr; const int col0 = u.pn * BM + wc * 32 + 8 * fq;
#pragma unroll
        for (int ai = 0; ai < 2; ++ai)
#pragma unroll
            for (int m = 0; m < 4; ++m) { bf16_t* rowp = O + (size_t)(row0 + ai * HALF + m * 16) * ldc + col0;
#pragma unroll
                for (int bj = 0; bj < 2; ++bj) { const f32x4 v0 = acc[ai][bj][m][0], v1 = acc[ai][bj][m][1];
                    u32x4 w; w.x = cvt_pk_bf16(v0[0], v0[1]); w.y = cvt_pk_bf16(v0[2], v0[3]); w.z = cvt_pk_bf16(v1[0], v1[1]); w.w = cvt_pk_bf16(v1[2], v1[3]);
                    *(u32x4*)(rowp + bj * HALF) = w; } }
    }
};
__device__ __forceinline__ float silu_f(float g) { return g * __builtin_amdgcn_rcpf(1.0f + __builtin_amdgcn_exp2f(-1.44269504f * g)); }

typedef int i32x4 __attribute__((ext_vector_type(4)));
template <int MODE> struct AccT { typedef f32x4 type; };
template <> struct AccT<1> { typedef i32x4 type; };
template <int MODE> __device__ __forceinline__ typename AccT<MODE>::type mma_pair(const bf16x8 (&b)[2], const bf16x8 (&a)[2], typename AccT<MODE>::type c) {
    if constexpr (MODE == 1) { c = __builtin_amdgcn_mfma_i32_16x16x64_i8(__builtin_bit_cast(i32x4, b[0]), __builtin_bit_cast(i32x4, a[0]), c, 0, 0, 0);
        return __builtin_amdgcn_mfma_i32_16x16x64_i8(__builtin_bit_cast(i32x4, b[1]), __builtin_bit_cast(i32x4, a[1]), c, 0, 0, 0); }
    else { c = __builtin_amdgcn_mfma_f32_16x16x32_bf16(b[0], a[0], c, 0, 0, 0); return __builtin_amdgcn_mfma_f32_16x16x32_bf16(b[1], a[1], c, 0, 0, 0); }
}
struct EpiBf16Q {
    static constexpr bool PERM = true;
    bf16_t* O; int ldc; const float* sa; const float* sb; const PG8_LAS int* texp; int sbstride; float sconst;
    __device__ __forceinline__ void operator()(const i32x4 (&acc)[2][2][4][2], const Unit& u, int wr, int wc, int fr, int fq) const {
        const int row0 = u.pm * BM + wr * 64 + fr; const int col0 = u.pn * BM + wc * 32 + 8 * fq;
        const float* sbe = sb + (texp ? (size_t)__builtin_amdgcn_readfirstlane(texp[u.pm]) * sbstride : (size_t)0);
        f32x4 cb[2][2];
#pragma unroll
        for (int bj = 0; bj < 2; ++bj) { cb[bj][0] = *(const f32x4*)(sbe + col0 + bj * HALF); cb[bj][1] = *(const f32x4*)(sbe + col0 + bj * HALF + 4); }
#pragma unroll
        for (int ai = 0; ai < 2; ++ai)
#pragma unroll
            for (int m = 0; m < 4; ++m) { const int row = row0 + ai * HALF + m * 16; const float ra = sa ? sa[row] : sconst; bf16_t* rowp = O + (size_t)row * ldc + col0;
#pragma unroll
                for (int bj = 0; bj < 2; ++bj) { const i32x4 a0 = acc[ai][bj][m][0], a1 = acc[ai][bj][m][1];
                    const f32x4 v0 = (f32x4){(float)a0[0], (float)a0[1], (float)a0[2], (float)a0[3]} * cb[bj][0] * ra, v1 = (f32x4){(float)a1[0], (float)a1[1], (float)a1[2], (float)a1[3]} * cb[bj][1] * ra;
                    u32x4 w; w.x = cvt_pk_bf16(v0[0], v0[1]); w.y = cvt_pk_bf16(v0[2], v0[3]); w.z = cvt_pk_bf16(v1[0], v1[1]); w.w = cvt_pk_bf16(v1[2], v1[3]);
                    *(u32x4*)(rowp + bj * HALF) = w; } }
    }
};
struct EpiSwiGLUQ8 {
    static constexpr bool PERM = false;
    signed char* Hd8; int ldh; const float* sa; const float* sb; const PG8_LAS int* texp; int sbstride; float hinv;
    __device__ __forceinline__ void operator()(const i32x4 (&acc)[2][2][4][2], const Unit& u, int wr, int wc, int fr, int fq) const {
        const int row0 = u.pm * BM + wr * 64 + fr;
        const float* sbe = sb + (texp ? (size_t)__builtin_amdgcn_readfirstlane(texp[u.pm]) * sbstride : (size_t)0) + u.pn * BM + wc * 32 + 4 * fq;
        f32x4 cg[2], cu[2];
#pragma unroll
        for (int bj = 0; bj < 2; ++bj) { cg[bj] = *(const f32x4*)(sbe + bj * HALF); cu[bj] = *(const f32x4*)(sbe + bj * HALF + 16); }
#pragma unroll
        for (int ai = 0; ai < 2; ++ai)
#pragma unroll
            for (int m = 0; m < 4; ++m) { const int row = row0 + ai * HALF + m * 16; const float ra = sa[row]; signed char* rowp = Hd8 + (size_t)row * ldh;
#pragma unroll
                for (int bj = 0; bj < 2; ++bj) { const i32x4 gi = acc[ai][bj][m][0], ui = acc[ai][bj][m][1];
                    const f32x4 g = (f32x4){(float)gi[0], (float)gi[1], (float)gi[2], (float)gi[3]} * cg[bj] * ra, up = (f32x4){(float)ui[0], (float)ui[1], (float)ui[2], (float)ui[3]} * cu[bj] * (ra * hinv);
                    const int hc = 16 * (8 * u.pn + 4 * bj + wc) + 4 * fq;
                    unsigned w = 0u;
#pragma unroll
                    for (int e = 0; e < 4; ++e) { const float q = fminf(fmaxf(__builtin_rintf(silu_f(g[e]) * up[e]), -127.0f), 127.0f); w |= ((unsigned)(int)q & 255u) << (8 * e); }
                    *(unsigned*)(rowp + hc) = w; } }
    }
};

template <class Epi, class Sched, bool ALIGN_EPI, bool EXPERT, int MODE = 0  >
__device__ __forceinline__ void gemm_phase(PG8_LAS unsigned char* lds, const Gemm g, const Sched& S, const Epi& E) {
    const int tid = threadIdx.x, wid = __builtin_amdgcn_readfirstlane(tid >> 6), lane = tid & 63, wr = wid >> 2, wc = wid & 3, fr = lane & 15, fq = lane >> 4;
    const int K = g.K, nt = K / BK;
    unsigned voffA[2], voffB[2];
#pragma unroll
    for (int i = 0; i < 2; ++i) { int R, C; stage_rc(tid * 16 + i * 8192, R, C); const int Rb = Epi::PERM ? ((R & ~31) + perm32(R & 31)) : R;
        voffA[i] = (unsigned)(R * K + C) * 2u; voffB[i] = (unsigned)(Rb * K + C) * 2u; }
    const size_t kstep = (size_t)(BK * 2);
    const size_t hstep = (size_t)HALF * K * 2;
    const size_t tstep = 2 * hstep;
    const unsigned ldsw = (unsigned)wid * 1024u;
    const int aoff = lds_byte(wr * 64 + fr, fq * 8), boff = lds_byte(wc * 32 + fr, fq * 8);
#define PG8_SA(b, h) (((b) * 2 + (h)) * HTB)
#define PG8_SB(b, h) ((4 + (b) * 2 + (h)) * HTB)
#define PG8_STAGE(bufoff, gbase, voff) do { _Pragma("unroll") for (int _i = 0; _i < 2; ++_i) \
        __builtin_amdgcn_global_load_lds((const unsigned*)((const char*)(gbase) + (voff)[_i]), (PG8_LAS unsigned*)(lds + (bufoff) + ldsw + _i * 8192), 16, 0, 0); } while (0)
#define PG8_LDA(dst, b, h) do { _Pragma("unroll") for (int m = 0; m < 4; ++m) _Pragma("unroll") for (int k = 0; k < 2; ++k) dst[m][k] = *(const PG8_LAS bf16x8*)(lds + PG8_SA(b, h) + aoff + m * 2048 + k * 1024); } while (0)
#define PG8_LDB(dst, b, h) do { _Pragma("unroll") for (int n = 0; n < 2; ++n) _Pragma("unroll") for (int k = 0; k < 2; ++k) dst[n][k] = *(const PG8_LAS bf16x8*)(lds + PG8_SB(b, h) + boff + n * 2048 + k * 1024); } while (0)
#define PG8_MMA(ai, bj, At, Bt) do { __builtin_amdgcn_s_setprio(1); _Pragma("unroll") for (int m = 0; m < 4; ++m) _Pragma("unroll") for (int n = 0; n < 2; ++n) \
        acc[ai][bj][m][n] = mma_pair<MODE>(Bt[n], At[m], acc[ai][bj][m][n]); __builtin_amdgcn_s_setprio(0); } while (0)
#define PG8_WAIT_V(n) asm volatile("s_waitcnt vmcnt(" #n ")" ::: "memory")
#define PG8_WAIT_L(n) asm volatile("s_waitcnt lgkmcnt(" #n ")" ::: "memory")
#define PG8_BAR __builtin_amdgcn_s_barrier()
#define PG8_SCHED __builtin_amdgcn_sched_barrier(0)
#define PG8_BPTR(u) ((const char*)g.Bt + (EXPERT ? (size_t)__builtin_amdgcn_readfirstlane(g.texp[(u).pm]) * g.estride * 2 : (size_t)0) + (size_t)(u).pn * tstep)
    Unit cur, nxt; int ui = 0;
    if (!S.next(0, cur)) return;
    typedef typename AccT<MODE>::type acc_t;
    acc_t acc[2][2][4][2];
#pragma unroll
    for (int a = 0; a < 2; ++a)
#pragma unroll
        for (int b = 0; b < 2; ++b)
#pragma unroll
            for (int m = 0; m < 4; ++m)
#pragma unroll
                for (int n = 0; n < 2; ++n) acc[a][b][m][n] = acc_t{};
    bf16x8 At[4][2], B0[2][2], B1[2][2];
    const char* cA = (const char*)g.A + (size_t)cur.pm * tstep; const char* cB = PG8_BPTR(cur);
    PG8_STAGE(PG8_SB(0, 0), cB, voffB); PG8_STAGE(PG8_SB(0, 1), cB + hstep, voffB); PG8_STAGE(PG8_SA(0, 0), cA, voffA); PG8_STAGE(PG8_SA(0, 1), cA + hstep, voffA);
    if (wr == 1) PG8_BAR;
    PG8_WAIT_V(2); PG8_BAR;
    PG8_STAGE(PG8_SB(1, 0), cB + kstep, voffB); PG8_STAGE(PG8_SA(1, 0), cA + kstep, voffA); PG8_STAGE(PG8_SB(1, 1), cB + hstep + kstep, voffB);
    PG8_WAIT_V(6); PG8_BAR;
    for (;;) {
        const bool has_next = S.next(ui + 1, nxt);
        const char* nA = has_next ? (const char*)g.A + (size_t)nxt.pm * tstep : cA; const char* nB = has_next ? PG8_BPTR(nxt) : cB;
        for (int t = 0; t < nt; t += 2) {
            const bool last = (t == nt - 2);
            const char* a1 = cA + (size_t)(t + 1) * kstep;
            const char* a2 = last ? nA : cA + (size_t)(t + 2) * kstep; const char* b2 = last ? nB : cB + (size_t)(t + 2) * kstep;
            const char* a3 = a2 + kstep; const char* b3 = b2 + kstep;
            PG8_LDB(B0, 0, 0); PG8_LDB(B1, 0, 1); PG8_SCHED; PG8_LDA(At, 0, 0); PG8_STAGE(PG8_SA(1, 1), a1 + hstep, voffA);
            PG8_WAIT_V(8); PG8_WAIT_L(0); PG8_BAR; PG8_MMA(0, 0, At, B0); PG8_MMA(0, 1, At, B1); PG8_BAR; PG8_SCHED;
            PG8_LDA(At, 0, 1); PG8_STAGE(PG8_SB(0, 0), b2, voffB); PG8_STAGE(PG8_SB(0, 1), b2 + hstep, voffB); PG8_STAGE(PG8_SA(0, 0), a2, voffA);
            PG8_WAIT_V(8); PG8_WAIT_L(0); PG8_BAR; PG8_MMA(1, 0, At, B0); PG8_MMA(1, 1, At, B1); PG8_BAR; PG8_SCHED;
            PG8_LDB(B0, 1, 0); PG8_LDB(B1, 1, 1); PG8_SCHED; PG8_LDA(At, 1, 0); PG8_STAGE(PG8_SA(0, 1), a2 + hstep, voffA);
            PG8_WAIT_V(8); PG8_WAIT_L(0); PG8_BAR; PG8_MMA(0, 0, At, B0); PG8_MMA(0, 1, At, B1); PG8_BAR; PG8_SCHED;
            PG8_LDA(At, 1, 1); PG8_STAGE(PG8_SB(1, 0), b3, voffB); PG8_STAGE(PG8_SB(1, 1), b3 + hstep, voffB); PG8_STAGE(PG8_SA(1, 0), a3, voffA);
            PG8_WAIT_V(8); PG8_WAIT_L(0); PG8_BAR; PG8_MMA(1, 0, At, B0); PG8_MMA(1, 1, At, B1); PG8_BAR; PG8_SCHED;
        }
        if constexpr (ALIGN_EPI) { if (wr == 0) PG8_BAR; }
        E(acc, cur, wr, wc, fr, fq);
#ifdef PROBE_EPI2
        if constexpr (EXPERT && !Epi::PERM) { asm volatile("" ::: "memory"); E(acc, cur, wr, wc, fr, fq); }
#endif
        if (!has_next) break;
#pragma unroll
        for (int a = 0; a < 2; ++a)
#pragma unroll
            for (int b = 0; b < 2; ++b)
#pragma unroll
                for (int m = 0; m < 4; ++m)
#pragma unroll
                    for (int n = 0; n < 2; ++n) acc[a][b][m][n] = acc_t{};
        cur = nxt; cA = nA; cB = nB; ++ui;
        if constexpr (ALIGN_EPI) { if (wr == 1) PG8_BAR; }
    }
    PG8_WAIT_V(0);
    if constexpr (!ALIGN_EPI) { if (wr == 0) PG8_BAR; }
    PG8_BAR;
#undef PG8_BPTR
#undef PG8_SA
#undef PG8_SB
#undef PG8_STAGE
#undef PG8_LDA
#undef PG8_LDB
#undef PG8_MMA
#undef PG8_WAIT_V
#undef PG8_WAIT_L
#undef PG8_BAR
#undef PG8_SCHED
}
}

constexpr int NWAVES = 8;
constexpr int D = 1024, NB = 16, SEQ = 4096, CTXL = 256, GW = 64;
constexpr int TL = NB * SEQ, TC = NB * CTXL, TT = TL + TC;
constexpr int PROJ_SRC = 3104, PP = 3328;
constexpr int C_GQ = 0, C_GK = 256, C_GV = 512, C_GR = 1024, C_NQ = 1536, C_NK = 2048, C_NV = 2560, C_LR = 3072;
constexpr int DFF = 2816, DFE = 3584, NE = 8;
constexpr float EPS = 1e-6f;
constexpr int MOE_MAXT = 520, MOE_SLT = 192, MOE_NSL = 3;

constexpr size_t MiB = 1u << 20;
constexpr size_t WS_CTL = 0, CTL_ZERO_BYTES = 1 * MiB;
constexpr size_t WS_MOD = 1 * MiB;
constexpr size_t WS_ROPE = WS_MOD + 2 * 17 * 6144 * 4;
constexpr size_t WS_MOE = 2 * MiB;
constexpr size_t MOE_E = 0, MOE_W = 512 * 1024, MOE_RANK = 1024 * 1024, MOE_POS = 1536 * 1024, MOE_HIST = 2048 * 1024, MOE_ROWTOK = 2048 * 1024 + 16384, MOE_TEXP = MOE_ROWTOK + (size_t)MOE_MAXT * 256 * 4 + 4096, MOE_META = MOE_TEXP + 4096;
constexpr size_t WS_VCT = 6 * MiB;
constexpr size_t WS_SROW = WS_VCT;
constexpr size_t WS_SSORT = WS_VCT + 512 * 1024;
constexpr size_t WS_SB_IN = WS_VCT + 1536 * 1024;
constexpr size_t WS_SB_GU0 = WS_SB_IN + 32 * 1024;
constexpr size_t WS_SB_GU1 = WS_SB_IN + 64 * 1024;
constexpr size_t WS_SB_D0 = WS_SB_IN + 300 * 1024;
constexpr size_t WS_SB_D1 = WS_SB_IN + 320 * 1024;
constexpr float HID_RANGE = 8.0f;
constexpr size_t WS_CTXB = 10 * MiB;
constexpr size_t WS_WIN = 26 * MiB;
constexpr size_t WS_WOUT = WS_WIN + 2 * (size_t)PP * D * 2;
constexpr size_t WS_WGU0 = WS_WOUT + 2 * (size_t)D * D * 2;
constexpr size_t WS_WD0 = WS_WGU0 + (size_t)2 * DFF * D * 2;
constexpr size_t WS_WGU1 = WS_WD0 + (size_t)D * DFF * 2;
constexpr size_t WS_WD1 = WS_WGU1 + (size_t)NE * 2 * DFE * D * 2;
constexpr size_t WS_WEND = WS_WD1 + (size_t)NE * D * DFE * 2;
constexpr size_t WS_H = 228 * MiB;
constexpr size_t WS_BIG = 364 * MiB;
constexpr size_t WS_O = 806 * MiB;
constexpr size_t WS_ASORT = WS_BIG;
constexpr size_t WS_OUTP = WS_BIG + 130 * MiB;
constexpr size_t WS_HIDS = WS_BIG + 390 * MiB;
constexpr size_t WS_HRES_A = 296 * MiB;
constexpr size_t WS_HRES_B = WS_HIDS + (size_t)MOE_SLT * 256 * DFE;
constexpr size_t WS_NAPART = 942 * MiB;
constexpr size_t WS_END = 1024 * MiB;
static_assert(WS_WEND <= WS_H && WS_H + (size_t)TT * D * 2 <= WS_BIG && WS_BIG + (size_t)TT * PP * 2 <= WS_O && WS_O + (size_t)2 * TT * 512 * 2 <= WS_END, "ws map");
static_assert(WS_ASORT + (size_t)MOE_MAXT * 256 * D <= WS_OUTP && WS_OUTP + (size_t)MOE_MAXT * 256 * D * 2 <= WS_HIDS && WS_HIDS + (size_t)MOE_SLT * 256 * DFE <= WS_END && WS_ROPE + 8192 <= WS_MOE && MOE_META + 256 <= 4 * MiB, "ws map 2");
static_assert(WS_H + (size_t)TT * D <= WS_HRES_A && WS_HRES_A + (size_t)(TL / 2) * D * 2 <= WS_BIG && WS_HRES_B + (size_t)(TL / 2) * D * 2 <= WS_END && MOE_SLT * MOE_NSL >= MOE_MAXT, "ws map 3");
constexpr int CW_TMO = 0, CW_BAR = 4096;

constexpr int RING_OFF = 0, RING_BYTES = 131072;
constexpr int IDX_OFF = 159744, IDX_BYTES = 256 * 4;
constexpr int LDSCTL_OFF = IDX_OFF + 1024, MISC_OFF = LDSCTL_OFF + 64, PTAB_OFF = MISC_OFF + 128;
constexpr int LDS_BYTES = 163840;
static_assert(PTAB_OFF + 256 <= LDS_BYTES, "LDS map");

#define LAS __attribute__((address_space(3)))
typedef unsigned short bf16;
typedef float f32x4 __attribute__((ext_vector_type(4)));
typedef short bf16x8 __attribute__((ext_vector_type(8)));
typedef short s16x4 __attribute__((ext_vector_type(4)));
typedef unsigned u32x4 __attribute__((ext_vector_type(4)));
typedef unsigned u32x2 __attribute__((ext_vector_type(2)));
#define RLX_AGENT __ATOMIC_RELAXED, __HIP_MEMORY_SCOPE_AGENT
#define LDS_WAIT() asm volatile("s_waitcnt lgkmcnt(0)" ::: "memory")
#define VM_WAIT() asm volatile("s_waitcnt vmcnt(0)" ::: "memory")
typedef float f32x2 __attribute__((ext_vector_type(2)));
typedef __bf16 bf16x2_t __attribute__((ext_vector_type(2)));
__device__ __forceinline__ unsigned pk2(float lo, float hi) { const f32x2 v = {lo, hi}; return __builtin_bit_cast(unsigned, __builtin_convertvector(v, bf16x2_t)); }
__device__ __forceinline__ unsigned f2bf(float f) { return pk2(f, 0.f) & 0xffffu; }
__device__ __forceinline__ float bflo(unsigned w) { return __builtin_bit_cast(float, w << 16); }
__device__ __forceinline__ float bfhi(unsigned w) { return __builtin_bit_cast(float, w & 0xffff0000u); }
__device__ __forceinline__ f32x4 mfma16(bf16x8 a, bf16x8 b, f32x4 c) { return __builtin_amdgcn_mfma_f32_16x16x32_bf16(a, b, c, 0, 0, 0); }
__device__ __forceinline__ s16x4 tr_read(const LAS unsigned char* p) { return __builtin_amdgcn_ds_read_tr16_b64_v4i16((LAS s16x4*)p); }

#define XB_TMO      128
#define XB_XCNT(j)  (256  + 64 * (j))
#define XB_XSUB(j)  (1280 + 64 * (j))
#define XB_XGEN(j)  (2304 + 64 * (j))
#define XB_TOP      3328
#define XB_TOPGEN   3392
#define XCD_BAR_WORDS 3456
#define XB_SPIN_CAP (1u << 18)
__device__ __forceinline__ unsigned xb_ld(unsigned* p)              { return __hip_atomic_load(p, __ATOMIC_RELAXED, __HIP_MEMORY_SCOPE_AGENT); }
__device__ __forceinline__ unsigned xb_add(unsigned* p, unsigned v) { return __hip_atomic_fetch_add(p, v, __ATOMIC_RELAXED, __HIP_MEMORY_SCOPE_AGENT); }
__device__ __forceinline__ unsigned xb_xcc_id() { return (unsigned)__builtin_amdgcn_s_getreg((3 << 11) | 20) & 0xFu; }
#define XB_SPIN(cond, bar) do { unsigned _sp = 0; while (cond) { __builtin_amdgcn_s_sleep(1); \
    if ((++_sp & 255u) == 0u) { if (xb_ld(&(bar)[XB_TMO])) break; if (_sp > XB_SPIN_CAP) { atomicAdd(&(bar)[XB_TMO], 1u); break; } } } } while (0)
struct XcdBarrier { unsigned* bar; unsigned x; volatile LAS unsigned* st; };
__device__ __forceinline__ XcdBarrier xcd_barrier_post(unsigned* bar, volatile LAS unsigned* st) {
    XcdBarrier b; b.bar = bar; b.x = xb_xcc_id(); b.st = st;
    if (threadIdx.x == 0) (void)xb_add(&bar[XB_XCNT(b.x)], 1u);
    return b;
}
__device__ __forceinline__ void xcd_barrier_complete(unsigned* bar, unsigned x, unsigned& nloc, unsigned& nx) {
    const unsigned G = gridDim.x * gridDim.y * gridDim.z;
    unsigned sum, cnt, mine, sp = 0u;
    for (;;) {
        sum = 0u; cnt = 0u; mine = 0u;
#pragma unroll
        for (unsigned j = 0; j < 16; ++j) { const unsigned c = xb_ld(&bar[XB_XCNT(j)]); sum += c; cnt += (c > 0u) ? 1u : 0u; mine = (j == x) ? c : mine; }
        if (sum == G) break;
        __builtin_amdgcn_s_sleep(1);
        if ((++sp & 255u) == 0u) { if (xb_ld(&bar[XB_TMO])) break; if (sp > XB_SPIN_CAP) { atomicAdd(&bar[XB_TMO], 1u); break; } }
    }
    nloc = mine > 0u ? mine : 1u; nx = cnt > 0u ? cnt : 1u;
}
__device__ __forceinline__ void xcd_barrier(const XcdBarrier& b) {
    asm volatile("s_waitcnt vmcnt(0)" ::: "memory");
    __syncthreads();
    if (threadIdx.x == 0) {
        unsigned* bar = b.bar;
        __builtin_amdgcn_s_waitcnt(0);
        unsigned nloc = b.st[0], nx = b.st[1];
        if (nloc == 0u) { xcd_barrier_complete(bar, b.x, nloc, nx); b.st[0] = nloc; b.st[1] = nx; }
        const unsigned old = xb_add(&bar[XB_XSUB(b.x)], 1u);
        const unsigned gen = old / nloc;
        if (old + 1u == (gen + 1u) * nloc) {
            __builtin_amdgcn_fence(__ATOMIC_RELEASE, "agent");
            asm volatile("s_waitcnt vmcnt(0)" ::: "memory");
            const unsigned og = xb_add(&bar[XB_TOP], 1u);
            const unsigned tg = og / nx;
            if (og + 1u == (tg + 1u) * nx) xb_add(&bar[XB_TOPGEN], 1u);
            else XB_SPIN(xb_ld(&bar[XB_TOPGEN]) == tg, bar);
            __builtin_amdgcn_fence(__ATOMIC_ACQUIRE, "agent");
            xb_add(&bar[XB_XGEN(b.x)], 1u);
            asm volatile("s_waitcnt vmcnt(0)" ::: "memory");
        } else {
            XB_SPIN(xb_ld(&bar[XB_XGEN(b.x)]) == gen, bar);
            __builtin_amdgcn_fence(__ATOMIC_ACQUIRE, "agent");
            asm volatile("s_waitcnt vmcnt(0)" ::: "memory");
        }
    }
    __syncthreads();
}

struct Frame {
    LAS unsigned char* lds;
    int tid, lane, wave, vcu, G;
    unsigned char* ws;
    float* out;
    __device__ __forceinline__ const float* inp(int i) const { const LAS unsigned* pt = (const LAS unsigned*)(lds + PTAB_OFF) + 2 * i; const unsigned lo = __builtin_amdgcn_readfirstlane(pt[0]), hi = __builtin_amdgcn_readfirstlane(pt[1]); return (const float*)(((unsigned long long)hi << 32) | lo); }
};
enum { I_X = 0, I_C, I_CTX, I_CCTX, I_WADA, I_BADA, I_GPREMIX, I_GPOSTMIX, I_GPREFFN, I_GPOSTFFN, I_WIN, I_GWG, I_GBG, I_GGN, I_RPB, I_WOUT, I_FWG, I_FWU, I_FWD, I_MWR, I_MWG, I_MWU, I_MWD };

template <int CTRL> __device__ __forceinline__ float dpp_f(float v) { return __builtin_bit_cast(float, __builtin_amdgcn_update_dpp(0, __builtin_bit_cast(int, v), CTRL, 0xf, 0xf, true)); }
struct OpAdd { static __device__ __forceinline__ float f(float a, float b) { return a + b; } };
struct OpMax { static __device__ __forceinline__ float f(float a, float b) { return fmaxf(a, b); } };
template <class Op> __device__ __forceinline__ float red_x16(float v) { const unsigned u = __builtin_bit_cast(unsigned, v); const auto r = __builtin_amdgcn_permlane16_swap(u, u, false, false);
    return Op::f(__builtin_bit_cast(float, (unsigned)r[0]), __builtin_bit_cast(float, (unsigned)r[1])); }
template <class Op> __device__ __forceinline__ float red_x32(float v) { const unsigned u = __builtin_bit_cast(unsigned, v); const auto r = __builtin_amdgcn_permlane32_swap(u, u, false, false);
    return Op::f(__builtin_bit_cast(float, (unsigned)r[0]), __builtin_bit_cast(float, (unsigned)r[1])); }
template <class Op> __device__ __forceinline__ float red_row16(float v) {
    v = Op::f(v, dpp_f<0xB1>(v)); v = Op::f(v, dpp_f<0x4E>(v)); v = Op::f(v, dpp_f<0x141>(v)); return Op::f(v, dpp_f<0x140>(v)); }
template <class Op> __device__ __forceinline__ float red_wave(float v) { return red_x32<Op>(red_x16<Op>(red_row16<Op>(v))); }
__device__ __forceinline__ float wave_sum(float v) { return red_wave<OpAdd>(v); }

__device__ __forceinline__ int dst_row(int n, int mode) {
    if (mode == 0) return n;
    if (mode == 1) return n < 1536 ? n : (n < 1568 ? n + 1536 : n - 32);
    return 32 * (n >> 4) + (n & 15) + (mode == 3 ? 16 : 0);
}
__device__ __forceinline__ void p0_transpose_item(const float* W, int K, int N, bf16* WT, int mode, LAS float* scr, int item, int lane) {
    const int nblk = N / 32, kb = item / nblk, nb = item % nblk, k0 = 64 * kb, n0 = 32 * nb;
    const int kr = lane >> 3, n4 = lane & 7;
    f32x4 v[8];
#pragma unroll
    for (int i = 0; i < 8; ++i) v[i] = *(const f32x4*)(W + (size_t)(k0 + 8 * i + kr) * N + n0 + 4 * n4);
#pragma unroll
    for (int i = 0; i < 8; ++i) { LAS float* d = scr + (8 * i + kr) * 33 + 4 * n4; d[0] = v[i][0]; d[1] = v[i][1]; d[2] = v[i][2]; d[3] = v[i][3]; }
    LDS_WAIT(); asm volatile("" ::: "memory");
    const int c = lane & 7;
#pragma unroll
    for (int j = 0; j < 4; ++j) { const int n = (lane >> 3) + 8 * j; const LAS float* s = scr + (8 * c) * 33 + n;
        u32x4 o; o.x = pg8::cvt_pk_bf16(s[0 * 33], s[1 * 33]); o.y = pg8::cvt_pk_bf16(s[2 * 33], s[3 * 33]); o.z = pg8::cvt_pk_bf16(s[4 * 33], s[5 * 33]); o.w = pg8::cvt_pk_bf16(s[6 * 33], s[7 * 33]);
        *(u32x4*)(WT + (size_t)dst_row(n0 + n, mode) * K + k0 + 8 * c) = o; }
    LDS_WAIT(); asm volatile("" ::: "memory");
}

constexpr int P0_NH = 2;
struct P0Item { const float* W; int K, N; signed char* W8; float* sb; int mode, nb; };
struct P0Hold { f32x4 v[P0_NH][8]; };
__device__ __forceinline__ void p0q_load(const P0Item& it, P0Hold& H, int wave, int lane) {
    const int n0 = 32 * it.nb, kr = lane >> 3, n4 = lane & 7, nsub = it.K / 64;
#pragma unroll
    for (int h = 0; h < P0_NH; ++h) { const int j = min(wave + 8 * h, nsub - 1); const int k0 = 64 * j;
#pragma unroll
        for (int i = 0; i < 8; ++i) H.v[h][i] = *(const f32x4*)(it.W + (size_t)(k0 + 8 * i + kr) * it.N + n0 + 4 * n4); }
}
__device__ __forceinline__ void p0q_finish(const P0Item& it, const P0Hold& H, LAS float* scr, LAS float* AM, int wave, int lane) {
    const float* W = it.W; const int K = it.K, N = it.N, mode = it.mode; signed char* W8 = it.W8;
    const int n0 = 32 * it.nb, kr = lane >> 3, n4 = lane & 7, nsub = K / 64;
    f32x4 am = (f32x4){0.f, 0.f, 0.f, 0.f};
#pragma unroll
    for (int h = 0; h < P0_NH; ++h)
#pragma unroll
        for (int i = 0; i < 8; ++i) { const f32x4 v = H.v[h][i];
            am[0] = fmaxf(am[0], fabsf(v[0])); am[1] = fmaxf(am[1], fabsf(v[1])); am[2] = fmaxf(am[2], fabsf(v[2])); am[3] = fmaxf(am[3], fabsf(v[3])); }
    for (int j = wave + 8 * P0_NH; j < nsub; j += 8) { const int k0 = 64 * j;
#pragma unroll
        for (int i = 0; i < 8; ++i) { const f32x4 v = *(const f32x4*)(W + (size_t)(k0 + 8 * i + kr) * N + n0 + 4 * n4);
            am[0] = fmaxf(am[0], fabsf(v[0])); am[1] = fmaxf(am[1], fabsf(v[1])); am[2] = fmaxf(am[2], fabsf(v[2])); am[3] = fmaxf(am[3], fabsf(v[3])); } }
#pragma unroll
    for (int q = 0; q < 4; ++q) { float a = am[q]; a = fmaxf(a, dpp_f<0x128>(a)); a = red_x32<OpMax>(red_x16<OpMax>(a)); am[q] = a; }
    if (kr == 0) *(LAS f32x4*)(AM + wave * 32 + 4 * n4) = am;
    __syncthreads();
#pragma unroll
    for (int w2 = 0; w2 < 8; ++w2) { const f32x4 o = *(const LAS f32x4*)(AM + w2 * 32 + 4 * n4); am[0] = fmaxf(am[0], o[0]); am[1] = fmaxf(am[1], o[1]); am[2] = fmaxf(am[2], o[2]); am[3] = fmaxf(am[3], o[3]); }
    f32x4 inv;
#pragma unroll
    for (int q = 0; q < 4; ++q) inv[q] = am[q] > 0.f ? 127.0f / am[q] : 0.f;
    if (wave == 0 && kr == 0) {
#pragma unroll
        for (int q = 0; q < 4; ++q) it.sb[dst_row(n0 + 4 * n4 + q, mode)] = am[q] * (1.0f / 127.0f); }
    const int c = lane & 7;
    auto emit = [&](const f32x4 (&v)[8], int k0) {
#pragma unroll
        for (int i = 0; i < 8; ++i) { LAS float* d = scr + (8 * i + kr) * 33 + 4 * n4; d[0] = v[i][0]; d[1] = v[i][1]; d[2] = v[i][2]; d[3] = v[i][3]; }
        LDS_WAIT(); asm volatile("" ::: "memory");
#pragma unroll
        for (int jj = 0; jj < 4; ++jj) { const int n = (lane >> 3) + 8 * jj; const LAS float* s = scr + (8 * c) * 33 + n;
            unsigned lo = 0u, hi = 0u;
#pragma unroll
            for (int e = 0; e < 4; ++e) { lo |= ((unsigned)(int)__builtin_rintf(s[e * 33]) & 255u) << (8 * e); hi |= ((unsigned)(int)__builtin_rintf(s[(4 + e) * 33]) & 255u) << (8 * e); }
            *(u32x2*)(W8 + (size_t)dst_row(n0 + n, mode) * K + k0 + 8 * c) = (u32x2){lo, hi}; }
        LDS_WAIT(); asm volatile("" ::: "memory"); };
#pragma unroll
    for (int h = 0; h < P0_NH; ++h) { f32x4 v[8];
#pragma unroll
        for (int i = 0; i < 8; ++i) v[i] = H.v[h][i] * inv;
        emit(v, 64 * (wave + 8 * h)); }
    for (int j = wave + 8 * P0_NH; j < nsub; j += 8) { const int k0 = 64 * j;
        f32x4 v[8];
#pragma unroll
        for (int i = 0; i < 8; ++i) v[i] = *(const f32x4*)(W + (size_t)(k0 + 8 * i + kr) * N + n0 + 4 * n4) * inv;
        emit(v, k0); }
    __syncthreads();
}
__device__ __forceinline__ void p0_prologue(Frame& F) {
    if (F.vcu < 192) {
        LAS float* SL = (LAS float*)(F.lds);
        LAS float* PS = (LAS float*)(F.lds + 17 * 1024 * 4);
        for (int i = F.tid; i < 17 * 1024; i += 512) { const float v = i < 16 * 1024 ? F.inp(I_C)[i] : F.inp(I_CCTX)[i - 16 * 1024]; SL[i] = v / (1.0f + __expf(-v)); }
        __syncthreads();
        const int l = F.vcu / 96, cb = F.vcu % 96, col = 64 * cb + F.lane;
        const float* W = F.inp(I_WADA) + (size_t)l * D * 6144 + col;
        float acc[17];
#pragma unroll
        for (int r = 0; r < 17; ++r) acc[r] = 0.f;
#pragma unroll 4
        for (int k4 = 0; k4 < 32; ++k4) { const int k = 128 * F.wave + 4 * k4;
            const float w0 = W[(size_t)(k + 0) * 6144], w1 = W[(size_t)(k + 1) * 6144], w2 = W[(size_t)(k + 2) * 6144], w3 = W[(size_t)(k + 3) * 6144];
#pragma unroll
            for (int r = 0; r < 17; ++r) { const f32x4 s = *(const LAS f32x4*)(SL + r * 1024 + k); acc[r] += s[0] * w0 + s[1] * w1 + s[2] * w2 + s[3] * w3; } }
#pragma unroll
        for (int r = 0; r < 17; ++r) PS[(F.wave * 17 + r) * 64 + F.lane] = acc[r];
        __syncthreads();
        float* mod = (float*)(F.ws + WS_MOD);
        for (int i = F.tid; i < 17 * 64; i += 512) { const int r = i >> 6, c = i & 63; float s = 0.f;
#pragma unroll
            for (int w = 0; w < 8; ++w) s += PS[(w * 17 + r) * 64 + c];
            mod[((size_t)l * 17 + r) * 6144 + 64 * cb + c] = s + F.inp(I_BADA)[l * 6144 + 64 * cb + c]; }
        __syncthreads();
    }
    if (F.vcu == 255) { float* rt = (float*)(F.ws + WS_ROPE);
        for (int i = F.tid; i < 1024; i += 512) { const int pos = i >> 4, fi = i & 15; const float inv = exp2f(-(float)fi * (13.287712379549449f / 16.0f)); const float a = (float)pos * inv; rt[2 * i] = cosf(a); rt[2 * i + 1] = sinf(a); } }
    { signed char* win = (signed char*)(F.ws + WS_WIN); const int gt = F.vcu * 512 + F.tid, NT = F.G * 512;
      for (int i = gt; i < 2 * 224 * 64; i += NT) { const int l = i / (224 * 64), r = i % (224 * 64); *(u32x4*)(win + ((size_t)l * PP + PROJ_SRC) * D + (size_t)r * 16) = (u32x4){0u, 0u, 0u, 0u}; }
      if (gt < 2 * 224) ((float*)(F.ws + WS_SB_IN))[(gt / 224) * PP + PROJ_SRC + gt % 224] = 0.f; }
    LAS float* scr = (LAS float*)(F.lds + RING_OFF + F.wave * 16384);
    LAS float* AM = (LAS float*)(F.lds + 140000 + 0);
    constexpr int QA = 97, QC = 88, QE = 112, QF = 32;
    constexpr int NWI = 8 * QF + QF + 16 * QE + 2 * QC + 2 * QA;
    auto item = [&](int r) { P0Item q;
        if (r < 8 * QF) { const int e = r / QF; q = P0Item{F.inp(I_MWD) + (size_t)e * DFE * D, DFE, D, (signed char*)(F.ws + WS_WD1) + (size_t)e * D * DFE, (float*)(F.ws + WS_SB_D1) + (size_t)e * D, 0, r % QF}; return q; } r -= 8 * QF;
        if (r < QF) { q = P0Item{F.inp(I_FWD), DFF, D, (signed char*)(F.ws + WS_WD0), (float*)(F.ws + WS_SB_D0), 0, r}; return q; } r -= QF;
        if (r < 16 * QE) { const int m = r / QE, e = m >> 1, w = m & 1; q = P0Item{F.inp(w ? I_MWU : I_MWG) + (size_t)e * D * DFE, D, DFE, (signed char*)(F.ws + WS_WGU1) + (size_t)e * 2 * DFE * D, (float*)(F.ws + WS_SB_GU1) + (size_t)e * 2 * DFE, 2 + w, r % QE}; return q; } r -= 16 * QE;
        if (r < 2 * QC) { const int w = r / QC; q = P0Item{F.inp(w ? I_FWU : I_FWG), D, DFF, (signed char*)(F.ws + WS_WGU0), (float*)(F.ws + WS_SB_GU0), 2 + w, r % QC}; return q; } r -= 2 * QC;
        { const int l = r / QA; q = P0Item{F.inp(I_WIN) + (size_t)l * D * PROJ_SRC, D, PROJ_SRC, (signed char*)(F.ws + WS_WIN) + (size_t)l * PP * D, (float*)(F.ws + WS_SB_IN) + (size_t)l * PP, 1, r % QA}; return q; } };
    { LAS int* QS = (LAS int*)(F.lds + 140000 + 1024); int* qctr = (int*)(F.ws + WS_CTL + 600 * 1024);
      auto grab = [&]() { return __hip_atomic_fetch_add(qctr, 1, __ATOMIC_RELAXED, __HIP_MEMORY_SCOPE_AGENT); };
      if (F.tid == 0) { QS[0] = grab(); QS[1] = grab(); }
      __syncthreads();
      int it = QS[0], i1 = QS[1]; P0Item ia, ib; P0Hold ha, hb;
      if (it < NWI) { ia = item(it); p0q_load(ia, ha, F.wave, F.lane); }
      __syncthreads();
#pragma unroll 1
      while (it < NWI) {
          const bool v1 = i1 < NWI;
          if (v1) { ib = item(i1); p0q_load(ib, hb, F.wave, F.lane); }
          if (F.tid == 0) QS[0] = v1 ? grab() : NWI;
          p0q_finish(ia, ha, scr, AM, F.wave, F.lane);
          if (!v1) break;
          const int i2 = QS[0]; const bool v2 = i2 < NWI;
          if (v2) { ia = item(i2); p0q_load(ia, ha, F.wave, F.lane); }
          if (F.tid == 0) QS[1] = v2 ? grab() : NWI;
          p0q_finish(ib, hb, scr, AM, F.wave, F.lane);
          it = i2; i1 = QS[1]; } }
    const int gw = F.vcu * NWAVES + F.wave, NGW = F.G * NWAVES;
    constexpr int IB = 16 * 32;
    for (int it = gw; it < 2 * IB; it += NGW) { const int l = it / IB; p0_transpose_item(F.inp(I_WOUT) + (size_t)l * D * D, D, D, (bf16*)(F.ws + WS_WOUT) + (size_t)l * D * D, 0, scr, it % IB, F.lane); }
}

struct Row { f32x4 v[4]; };
__device__ __forceinline__ Row ld_f32(const float* p, int lane) { Row r;
#pragma unroll
    for (int j = 0; j < 4; ++j) r.v[j] = __builtin_nontemporal_load((const f32x4*)(p + 4 * lane + 256 * j));
    return r; }
__device__ __forceinline__ void st_f32(float* p, int lane, const Row& r) {
#pragma unroll
    for (int j = 0; j < 4; ++j) __builtin_nontemporal_store(r.v[j], (f32x4*)(p + 4 * lane + 256 * j)); }
__device__ __forceinline__ Row ld_bf16(const bf16* p, int lane) { Row r;
#pragma unroll
    for (int j = 0; j < 4; ++j) { const u32x2 w = *(const u32x2*)(p + 4 * lane + 256 * j); r.v[j] = (f32x4){bflo(w.x), bfhi(w.x), bflo(w.y), bfhi(w.y)}; }
    return r; }
__device__ __forceinline__ void st_bf16(bf16* p, int lane, const Row& r) {
#pragma unroll
    for (int j = 0; j < 4; ++j) { u32x2 w; w.x = pk2(r.v[j][0], r.v[j][1]); w.y = pk2(r.v[j][2], r.v[j][3]); *(u32x2*)(p + 4 * lane + 256 * j) = w; } }
__device__ __forceinline__ Row ld_bf16nt(const bf16* p, int lane) { Row r;
#pragma unroll
    for (int j = 0; j < 4; ++j) { const u32x2 w = __builtin_nontemporal_load((const u32x2*)(p + 4 * lane + 256 * j)); r.v[j] = (f32x4){bflo(w.x), bfhi(w.x), bflo(w.y), bfhi(w.y)}; }
    return r; }
__device__ __forceinline__ void st_bf16nt(bf16* p, int lane, const Row& r) {
#pragma unroll
    for (int j = 0; j < 4; ++j) { u32x2 w; w.x = pk2(r.v[j][0], r.v[j][1]); w.y = pk2(r.v[j][2], r.v[j][3]); __builtin_nontemporal_store(w, (u32x2*)(p + 4 * lane + 256 * j)); } }
__device__ __forceinline__ bf16* hres1(Frame& F, int row) { return (bf16*)(F.ws + (row < TL / 2 ? WS_HRES_A : WS_HRES_B - (size_t)(TL / 2) * D * 2)) + (size_t)row * D; }
__device__ __forceinline__ float row_rinv(const Row& r) { float s = 0.f;
#pragma unroll
    for (int j = 0; j < 4; ++j) s += (r.v[j][0] * r.v[j][0] + r.v[j][1] * r.v[j][1]) + (r.v[j][2] * r.v[j][2] + r.v[j][3] * r.v[j][3]);
    return 1.0f / sqrtf(wave_sum(s) * (1.0f / D) + EPS); }
__device__ __forceinline__ float wave_max(float v) { return red_wave<OpMax>(v); }
__device__ __forceinline__ void st_q8(signed char* p, float* srow, int lane, const Row& r) {
    float am = 0.f;
#pragma unroll
    for (int j = 0; j < 4; ++j) am = fmaxf(am, fmaxf(fmaxf(fabsf(r.v[j][0]), fabsf(r.v[j][1])), fmaxf(fabsf(r.v[j][2]), fabsf(r.v[j][3]))));
    am = wave_max(am);
    const float inv = am > 0.f ? 127.0f / am : 0.f;
#pragma unroll
    for (int j = 0; j < 4; ++j) { unsigned w = 0u;
#pragma unroll
        for (int e = 0; e < 4; ++e) w |= ((unsigned)(int)__builtin_rintf(r.v[j][e] * inv) & 255u) << (8 * e);
        *(unsigned*)(p + 4 * lane + 256 * j) = w; }
    if (lane == 0) *srow = am * (1.0f / 127.0f);
}
__device__ __forceinline__ const float* modp(Frame& F, int l, int r, int which) { return (const float*)(F.ws + WS_MOD) + (((size_t)l * 17 + r) * 6 + which) * 1024; }

__device__ __forceinline__ void t1_prenorm(Frame& F) {
    const int gw = F.vcu * NWAVES + F.wave; signed char* H8 = (signed char*)(F.ws + WS_H); float* SR = (float*)(F.ws + WS_SROW);
    const Row g = ld_f32(F.inp(I_GPREMIX), F.lane);
    for (int seg = 0; seg < 2; ++seg) {
        const int r0 = seg ? TL + 2 * gw : 32 * gw, nr = seg ? 2 : 32, mr = seg ? 16 : (gw >> 7);
        const Row sc = ld_f32(modp(F, 0, mr, 1), F.lane), sh = ld_f32(modp(F, 0, mr, 0), F.lane);
        const float* src0 = seg ? F.inp(I_CTX) + (size_t)(r0 - TL) * D : F.inp(I_X) + (size_t)r0 * D;
        Row xn = ld_f32(src0, F.lane);
        for (int i = 0; i < nr; ++i) { const int row = r0 + i;
            Row x = xn; if (i + 1 < nr) xn = ld_f32(src0 + (size_t)(i + 1) * D, F.lane);
            const float ri = row_rinv(x);
#pragma unroll
            for (int j = 0; j < 4; ++j) x.v[j] = (x.v[j] * ri * g.v[j]) * (1.0f + sc.v[j]) + sh.v[j];
            st_q8(H8 + (size_t)row * D, SR + row, F.lane, x); }
    }
}
__device__ __forceinline__ void t2_postmix(Frame& F, int l) {
    const int gw = F.vcu * NWAVES + F.wave; signed char* H8 = (signed char*)(F.ws + WS_H); float* SR = (float*)(F.ws + WS_SROW); const bf16* Y = (const bf16*)(F.ws + WS_BIG);
    float* ctxb = (float*)(F.ws + WS_CTXB);
    const Row gpm = ld_f32(F.inp(I_GPOSTMIX) + l * D, F.lane), gpf = ld_f32(F.inp(I_GPREFFN) + l * D, F.lane);
    LAS float* WR = (LAS float*)(F.lds);
    LAS int* CNT = (LAS int*)(F.lds + 32768);
    if (l == 1) { for (int i = F.tid; i < 8192; i += 512) WR[i] = F.inp(I_MWR)[i]; if (F.tid < 8) CNT[F.tid] = 0; __syncthreads(); }
    const int nseg = l == 0 ? 2 : 1;
    for (int seg = 0; seg < nseg; ++seg) {
        const int r0 = seg ? TL + 2 * gw : 32 * gw, nr = seg ? 2 : 32, mr = seg ? 16 : (gw >> 7);
        const Row gt1 = ld_f32(modp(F, l, mr, 2), F.lane), sc2 = ld_f32(modp(F, l, mr, 4), F.lane), sh2 = ld_f32(modp(F, l, mr, 3), F.lane);
        const float* xs0 = seg ? F.inp(I_CTX) + (size_t)(r0 - TL) * D : F.inp(I_X) + (size_t)r0 * D;
        const bf16* xb0 = (const bf16*)F.out + (size_t)r0 * D;
        bf16* xdb = l == 0 ? (bf16*)F.out : hres1(F, r0) - (size_t)r0 * D;
        Row yn = ld_bf16(Y + (size_t)r0 * D, F.lane), xn = l == 0 ? ld_f32(xs0, F.lane) : ld_bf16nt(xb0, F.lane);
        for (int i = 0; i < nr; ++i) { const int row = r0 + i;
            const Row y = yn; Row x = xn;
            if (i + 1 < nr) { yn = ld_bf16(Y + (size_t)(row + 1) * D, F.lane); xn = l == 0 ? ld_f32(xs0 + (size_t)(i + 1) * D, F.lane) : ld_bf16nt(xb0 + (size_t)(i + 1) * D, F.lane); }
            const float ry = row_rinv(y);
#pragma unroll
            for (int j = 0; j < 4; ++j) x.v[j] = x.v[j] + gt1.v[j] * (y.v[j] * ry * gpm.v[j]);
            if (seg) st_f32(ctxb + (size_t)(row - TL) * D, F.lane, x); else st_bf16nt(xdb + (size_t)row * D, F.lane, x);
            const float r2 = row_rinv(x);
#pragma unroll
            for (int j = 0; j < 4; ++j) x.v[j] = (x.v[j] * r2 * gpf.v[j]) * (1.0f + sc2.v[j]) + sh2.v[j];
            st_q8(H8 + (size_t)row * D, SR + row, F.lane, x);
            if (l == 1) {
                float lg[8];
#pragma unroll
                for (int e = 0; e < 8; ++e) lg[e] = 0.f;
#pragma unroll
                for (int j = 0; j < 4; ++j)
#pragma unroll
                    for (int q = 0; q < 4; ++q) { const LAS float* w = WR + (4 * F.lane + 256 * j + q) * 8; const f32x4 w0 = *(const LAS f32x4*)w, w1 = *(const LAS f32x4*)(w + 4); const float hv = x.v[j][q];
                        lg[0] += hv * w0[0]; lg[1] += hv * w0[1]; lg[2] += hv * w0[2]; lg[3] += hv * w0[3]; lg[4] += hv * w1[0]; lg[5] += hv * w1[1]; lg[6] += hv * w1[2]; lg[7] += hv * w1[3]; }
#pragma unroll
                for (int e = 0; e < 8; ++e) lg[e] = wave_sum(lg[e]);
                int i1 = 0; float v1 = lg[0];
#pragma unroll
                for (int e = 1; e < 8; ++e) if (lg[e] > v1) { v1 = lg[e]; i1 = e; }
                int i2 = -1; float v2 = -3.0e38f;
#pragma unroll
                for (int e = 0; e < 8; ++e) if (e != i1 && lg[e] > v2) { v2 = lg[e]; i2 = e; }
                if (i2 < 0) i2 = i1 == 0 ? 1 : 0;
                const float w2 = 1.0f / (1.0f + __expf(v1 - v2)), w1 = 1.0f - w2;
                if (F.lane == 0) { int* te = (int*)(F.ws + WS_MOE + MOE_E); float* tw = (float*)(F.ws + WS_MOE + MOE_W); int* tr = (int*)(F.ws + WS_MOE + MOE_RANK);
                    te[2 * row] = i1; te[2 * row + 1] = i2; tw[2 * row] = w1; tw[2 * row + 1] = w2;
                    tr[2 * row] = atomicAdd((int*)(CNT + i1), 1); tr[2 * row + 1] = atomicAdd((int*)(CNT + i2), 1); }
            }
        }
    }
    if (l == 1) { __syncthreads(); if (F.tid < 8) ((int*)(F.ws + WS_MOE + MOE_HIST))[F.vcu * 8 + F.tid] = CNT[F.tid]; }
}
__device__ __forceinline__ void m2_lists(Frame& F) {
    LAS int* L = (LAS int*)(F.lds);
    const int* hist = (const int*)(F.ws + WS_MOE + MOE_HIST);
    if (F.wave == 0) {
        int tot[8], pre[8];
#pragma unroll
        for (int e = 0; e < 8; ++e) { int t = 0, p = 0;
#pragma unroll
            for (int q = 0; q < 4; ++q) { const int wg = F.lane + 64 * q; const int hv = hist[wg * 8 + e]; t += hv; p += (wg < F.vcu) ? hv : 0; }
#pragma unroll
            for (int o = 1; o < 64; o <<= 1) { t += __shfl_xor(t, o); p += __shfl_xor(p, o); }
            tot[e] = t; pre[e] = p; }
        if (F.lane == 0) { int base = 0;
#pragma unroll
            for (int e = 0; e < 8; ++e) { L[e] = base * 256; L[8 + e] = pre[e]; L[16 + e] = tot[e]; base += (tot[e] + 255) >> 8; }
            L[24] = base; }
    }
    __syncthreads();
    const int* te = (const int*)(F.ws + WS_MOE + MOE_E); const int* tr = (const int*)(F.ws + WS_MOE + MOE_RANK);
    int* tp = (int*)(F.ws + WS_MOE + MOE_POS); int* rtok = (int*)(F.ws + WS_MOE + MOE_ROWTOK);
    { const int pair = F.vcu * 512 + F.tid;
      const int e = min(max(te[pair], 0), 7); const int pos = min(max(L[e] + L[8 + e] + tr[pair], 0), MOE_MAXT * 256 - 1); tp[pair] = pos; rtok[pos] = pair >> 1; }
    if (F.vcu < 8) { const int e = F.vcu; const int cnt = L[16 + e], end = ((cnt + 255) >> 8) << 8; for (int i = cnt + F.tid; i < end; i += 512) rtok[L[e] + i] = 0; }
    if (F.vcu == 8) { int* tex = (int*)(F.ws + WS_MOE + MOE_TEXP);
        for (int t = F.tid; t < MOE_MAXT + 8; t += 512) { int e = 7;
#pragma unroll
            for (int q = 7; q >= 1; --q) if (t * 256 < L[q]) e = q - 1;
            tex[t] = e; }
        if (F.tid == 0) ((int*)(F.ws + WS_MOE + MOE_META))[0] = L[24]; }
}
__device__ __forceinline__ void t3_postffn(Frame& F, int l) {
    const int gw = F.vcu * NWAVES + F.wave; signed char* H8 = (signed char*)(F.ws + WS_H); float* SR = (float*)(F.ws + WS_SROW); float* ctxb = (float*)(F.ws + WS_CTXB);
    const Row gpo = ld_f32(F.inp(I_GPOSTFFN) + l * D, F.lane);
    const int nseg = l == 0 ? 2 : 1;
    for (int seg = 0; seg < nseg; ++seg) {
        const int r0 = seg ? TL + 2 * gw : 32 * gw, nr = seg ? 2 : 32, mr = seg ? 16 : (gw >> 7);
        const Row gt2 = ld_f32(modp(F, l, mr, 5), F.lane);
        Row gn, scn, shn;
        if (l == 0) { gn = ld_f32(F.inp(I_GPREMIX) + D, F.lane); scn = ld_f32(modp(F, 1, mr, 1), F.lane); shn = ld_f32(modp(F, 1, mr, 0), F.lane); }
        const int* tp = (const int*)(F.ws + WS_MOE + MOE_POS); const float* tw = (const float*)(F.ws + WS_MOE + MOE_W); const bf16* OP = (const bf16*)(F.ws + WS_OUTP); const bf16* FB = (const bf16*)(F.ws + WS_O);
        float* xp0 = seg ? ctxb + (size_t)(r0 - TL) * D : F.out + (size_t)r0 * D;
        const bf16* xb0 = l == 0 ? (const bf16*)F.out + (size_t)r0 * D : hres1(F, r0);
        const bool xf = seg != 0;
        int pan = 0, pbn = 0; float wan = 0.f, wbn = 0.f, wa = 0.f, wb = 0.f;
        Row fan, fbn, xn;
        if (l == 0) fan = ld_bf16(FB + (size_t)r0 * D, F.lane);
        else { const int pa0 = min(max(tp[2 * r0], 0), MOE_MAXT * 256 - 1), pb0 = min(max(tp[2 * r0 + 1], 0), MOE_MAXT * 256 - 1); wa = tw[2 * r0]; wb = tw[2 * r0 + 1]; fan = ld_bf16(OP + (size_t)pa0 * D, F.lane); fbn = ld_bf16(OP + (size_t)pb0 * D, F.lane);
            if (nr > 1) { pan = min(max(tp[2 * r0 + 2], 0), MOE_MAXT * 256 - 1); pbn = min(max(tp[2 * r0 + 3], 0), MOE_MAXT * 256 - 1); wan = tw[2 * r0 + 2]; wbn = tw[2 * r0 + 3]; } }
        xn = xf ? ld_f32(xp0, F.lane) : ld_bf16nt(xb0, F.lane);
        for (int i = 0; i < nr; ++i) { const int row = r0 + i;
            Row f = fan; Row x = xn; const float wac = wa, wbc = wb;
            if (l == 1) {
#pragma unroll
                for (int j = 0; j < 4; ++j) f.v[j] = fan.v[j] * wac + fbn.v[j] * wbc; }
            if (i + 1 < nr) {
                if (l == 0) fan = ld_bf16(FB + (size_t)(row + 1) * D, F.lane);
                else { fan = ld_bf16(OP + (size_t)pan * D, F.lane); fbn = ld_bf16(OP + (size_t)pbn * D, F.lane); wa = wan; wb = wbn;
                    if (i + 2 < nr) { pan = min(max(tp[2 * row + 4], 0), MOE_MAXT * 256 - 1); pbn = min(max(tp[2 * row + 5], 0), MOE_MAXT * 256 - 1); wan = tw[2 * row + 4]; wbn = tw[2 * row + 5]; } }
                xn = xf ? ld_f32(xp0 + (size_t)(i + 1) * D, F.lane) : ld_bf16nt(xb0 + (size_t)(i + 1) * D, F.lane); }
            const float rf = row_rinv(f);
            float* xp = xp0 + (size_t)i * D;
#pragma unroll
            for (int j = 0; j < 4; ++j) x.v[j] = x.v[j] + gt2.v[j] * (f.v[j] * rf * gpo.v[j]);
            if (xf || l == 1) st_f32(xp, F.lane, x); else st_bf16nt((bf16*)F.out + (size_t)row * D, F.lane, x);
            if (l == 0) { const float r3 = row_rinv(x);
#pragma unroll
                for (int j = 0; j < 4; ++j) x.v[j] = (x.v[j] * r3 * gn.v[j]) * (1.0f + scn.v[j]) + shn.v[j];
                st_q8(H8 + (size_t)row * D, SR + row, F.lane, x); }
        }
    }
}

__device__ __forceinline__ void moe_gather(Frame& F) {
    const int gw = F.vcu * NWAVES + F.wave, NGW = F.G * NWAVES; const int ntiles = ((const int*)(F.ws + WS_MOE + MOE_META))[0];
    const int* rtok = (const int*)(F.ws + WS_MOE + MOE_ROWTOK); const signed char* H8 = (const signed char*)(F.ws + WS_H); signed char* AS = (signed char*)(F.ws + WS_ASORT);
    const float* SR = (const float*)(F.ws + WS_SROW); float* SS = (float*)(F.ws + WS_SSORT);
    const int np = min(max(ntiles, 0), MOE_MAXT) * 256;
    for (int pos = gw; pos < np; pos += 4 * NGW) {
        int tok[4]; u32x4 a[4]; float sc[4];
#pragma unroll
        for (int q = 0; q < 4; ++q) { const int p = pos + q * NGW; tok[q] = p < np ? min(max(rtok[p], 0), TL - 1) : 0; }
#pragma unroll
        for (int q = 0; q < 4; ++q) { a[q] = *(const u32x4*)(H8 + (size_t)tok[q] * D + 16 * F.lane); sc[q] = SR[tok[q]]; }
#pragma unroll
        for (int q = 0; q < 4; ++q) { const int p = pos + q * NGW; if (p < np) { *(u32x4*)(AS + (size_t)p * D + 16 * F.lane) = a[q]; if (F.lane == 0) SS[p] = sc[q]; } } }
}

constexpr int GP = 144;
constexpr int G_VS = 0, G_QT = 9216, G_QH = 18432, G_KT = 27648, G_KH = 36864, G_AM = 46080, G_B = 55296, G_LR = 71680, G_TOT = 75776, G_ROPE = 77824, G_OB = 86016;
__device__ __forceinline__ bf16x8 cat8(s16x4 a, s16x4 b) { return __builtin_shufflevector(a, b, 0, 1, 2, 3, 4, 5, 6, 7); }
__device__ __forceinline__ bf16x8 pack8(f32x4 a, f32x4 b) { u32x4 p; p.x = pk2(a[0], a[1]); p.y = pk2(a[2], a[3]); p.z = pk2(b[0], b[1]); p.w = pk2(b[2], b[3]); return __builtin_bit_cast(bf16x8, p); }
__device__ __forceinline__ void gla_phase(Frame& F, int layer) {
    const bf16* proj = (const bf16*)(F.ws + WS_BIG); bf16* Obuf = (bf16*)(F.ws + WS_O); const float* rope = (const float*)(F.ws + WS_ROPE);
    LAS unsigned char* L = F.lds;
    const int t = F.tid, lane = F.lane, w = F.wave, g = lane >> 4, l15 = lane & 15, r4 = l15 >> 2, c4 = l15 & 3;
    LAS float* LB = (LAS float*)(L + G_B); LAS float* TOT = (LAS float*)(L + G_TOT);
    for (int u = F.vcu; u < 256; u += F.G) {
        const int b = u >> 4, h = (u >> 2) & 3, dir = (u >> 1) & 1, vh = u & 1;
        const int gtd = w & 3, gtsh = w >> 2;
        bf16x8 wgf;
        { const float* WG = F.inp(I_GWG) + ((size_t)(layer * 2 + dir) * 16 + 8 * (g & 1)) * 256 + 64 * h + 16 * gtd + l15;
          float wv[8];
#pragma unroll
          for (int j = 0; j < 8; ++j) wv[j] = g < 2 ? WG[j * 256] : 0.f;
          u32x4 pk; pk.x = pk2(wv[0], wv[1]); pk.y = pk2(wv[2], wv[3]); pk.z = pk2(wv[4], wv[5]); pk.w = pk2(wv[6], wv[7]); wgf = __builtin_bit_cast(bf16x8, pk); }
        const float bg = F.inp(I_GBG)[(layer * 2 + dir) * 256 + 64 * h + 16 * gtd + l15];
        bf16x8 cumA0, cumA1;
        { unsigned m[4];
#pragma unroll
          for (int j = 0; j < 4; ++j) m[j] = (4 * g + j <= l15) ? 0x3F80u : 0u;
          const u32x4 a0 = {m[0] | (m[1] << 16), m[2] | (m[3] << 16), 0u, 0u}, a1 = {0x3F803F80u, 0x3F803F80u, m[0] | (m[1] << 16), m[2] | (m[3] << 16)};
          cumA0 = __builtin_bit_cast(bf16x8, a0); cumA1 = __builtin_bit_cast(bf16x8, a1); }
        f32x4 S[4];
#pragma unroll
        for (int i = 0; i < 4; ++i) S[i] = (f32x4){0.f, 0.f, 0.f, 0.f};
        const int tensor = t >> 8, s = (t & 255) >> 2, p = t & 3, d0 = (p & 1) * 8 + (p >> 1) * 32;
        const int spos = dir ? 63 - s : s;
        const int sv = t >> 3, c8 = t & 7, svpos = dir ? 63 - sv : sv;
        const int sl = (t & 127) >> 1, hf = t & 1, slpos = dir ? 63 - sl : sl;
#define GLA_ROWBASE(ci_) ((ci_) < 4 ? TL + b * 256 + 64 * (dir ? 3 - (ci_) : (ci_)) : b * 4096 + 64 * (dir ? 63 - ((ci_) - 4) : ((ci_) - 4)))
        u32x4 c1n, c2n, vvn, lvn;
        { const int rb0 = GLA_ROWBASE(0); const bf16* src = proj + (size_t)(rb0 + spos) * PP + tensor * 256 + 64 * h + d0; c1n = *(const u32x4*)src; c2n = *(const u32x4*)(src + 16);
          vvn = *(const u32x4*)(proj + (size_t)(rb0 + svpos) * PP + C_GV + 128 * h + 64 * vh + 8 * c8);
          lvn = *(const u32x4*)(proj + (size_t)(rb0 + slpos) * PP + C_LR + 16 * dir + 8 * hf); }
        for (int i = t; i < 2048; i += 512) ((LAS float*)(L + G_ROPE))[i] = rope[i];
        int prev_rowbase = 0;
        for (int ci = 0; ci < 68; ++ci) {
            const int rowbase = GLA_ROWBASE(ci), rope_on = ci >= 4, rowpos = dir ? 63 - (ci - 4) : (ci - 4);
            const u32x4 c1 = c1n, c2 = c2n;
            *(LAS u32x4*)(L + G_VS + sv * GP + c8 * 16) = vvn;
            if (t < 128) *(LAS u32x4*)(L + G_LR + sl * 32 + hf * 16) = lvn;
            if (ci > 0) { const u32x4 ov = *(const LAS u32x4*)(L + G_OB + sv * GP + c8 * 16);
                *(u32x4*)(Obuf + (size_t)dir * TT * 512 + (size_t)(prev_rowbase + svpos) * 512 + 128 * h + 64 * vh + 8 * c8) = ov; }
            prev_rowbase = rowbase;
            if (ci + 1 < 68) { const int rb1 = GLA_ROWBASE(ci + 1); const bf16* src = proj + (size_t)(rb1 + spos) * PP + tensor * 256 + 64 * h + d0; c1n = *(const u32x4*)src; c2n = *(const u32x4*)(src + 16);
              vvn = *(const u32x4*)(proj + (size_t)(rb1 + svpos) * PP + C_GV + 128 * h + 64 * vh + 8 * c8);
              lvn = *(const u32x4*)(proj + (size_t)(rb1 + slpos) * PP + C_LR + 16 * dir + 8 * hf); }
            __syncthreads();
            f32x4 bl[2];
            { f32x4 gt[2];
#pragma unroll
              for (int i = 0; i < 2; ++i) { const bf16x8 af = *(const LAS bf16x8*)(L + G_LR + (16 * (2 * gtsh + i) + l15) * 32 + (g & 1) * 16);
                  f32x4 z = mfma16(af, wgf, (f32x4){0.f, 0.f, 0.f, 0.f});
#pragma unroll
                  for (int r = 0; r < 4; ++r) { const float zz = z[r] + bg; z[r] = (fminf(zz, 0.f) - __logf(1.0f + __expf(-fabsf(zz)))) * (1.0f / 16.0f); }
                  gt[i] = z; }
              const bf16x8 gB = pack8(gt[0], gt[1]);
              bl[0] = mfma16(cumA0, gB, (f32x4){0.f, 0.f, 0.f, 0.f}); bl[1] = mfma16(cumA1, gB, (f32x4){0.f, 0.f, 0.f, 0.f}); }
            if (gtsh == 0 && g == 3) TOT[16 * gtd + l15] = bl[1][3];
            __syncthreads();
            { const float off = gtsh ? TOT[16 * gtd + l15] : 0.f;
#pragma unroll
              for (int i = 0; i < 2; ++i)
#pragma unroll
                  for (int r = 0; r < 4; ++r) LB[(32 * gtsh + 16 * i + 4 * g + r) * 64 + 16 * gtd + l15] = bl[i][r] + off; }
            __syncthreads();
            { float x1[8], x2[8];
              x1[0] = bflo(c1.x); x1[1] = bfhi(c1.x); x1[2] = bflo(c1.y); x1[3] = bfhi(c1.y); x1[4] = bflo(c1.z); x1[5] = bfhi(c1.z); x1[6] = bflo(c1.w); x1[7] = bfhi(c1.w);
              x2[0] = bflo(c2.x); x2[1] = bfhi(c2.x); x2[2] = bflo(c2.y); x2[3] = bfhi(c2.y); x2[4] = bflo(c2.z); x2[5] = bfhi(c2.z); x2[6] = bflo(c2.w); x2[7] = bfhi(c2.w);
              if (rope_on) { const int pos = (p >> 1) ? spos : rowpos; const LAS float* rt = (const LAS float*)(L + G_ROPE) + (pos * 16 + (p & 1) * 8) * 2;
#pragma unroll
                  for (int jj = 0; jj < 8; ++jj) { const float cs = rt[2 * jj], sn = rt[2 * jj + 1]; const float a = x1[jj], bq = x2[jj]; x1[jj] = a * cs - bq * sn; x2[jj] = a * sn + bq * cs; } }
              const LAS float* Bs = LB + s * 64; const LAS float* Bref = LB + 32 * 64;
              float t1[8], t2[8];
              const float sgn = tensor ? -1.0f : 1.0f, sc0 = tensor ? 1.0f : 0.125f;
#pragma unroll
              for (int jj = 0; jj < 8; ++jj) { const float eA = (Bs[d0 + jj] - Bref[d0 + jj]) * sgn, eB = (Bs[d0 + 16 + jj] - Bref[d0 + 16 + jj]) * sgn;
                  t1[jj] = x1[jj] * sc0 * __expf(eA); t2[jj] = x2[jj] * sc0 * __expf(eB); }
              LAS unsigned char* pt = L + (tensor ? G_KT : G_QT) + s * GP + d0 * 2;
              *(LAS u32x4*)pt = (u32x4){pk2(t1[0], t1[1]), pk2(t1[2], t1[3]), pk2(t1[4], t1[5]), pk2(t1[6], t1[7])};
              *(LAS u32x4*)(pt + 32) = (u32x4){pk2(t2[0], t2[1]), pk2(t2[2], t2[3]), pk2(t2[4], t2[5]), pk2(t2[6], t2[7])}; }
            if (t < 192) { const int j = t >> 6, d = t & 63; const float br = LB[32 * 64 + d], bt = LB[63 * 64 + d];
                ((LAS float*)(L + G_QH))[t] = __expf(j == 0 ? br : (j == 1 ? bt - br : bt)); }
            __syncthreads();
#pragma unroll
            for (int i = 0; i < 2; ++i) { const int id = 2 * w + i, ts = id >> 2, tc = id & 3;
                f32x4 a = (f32x4){0.f, 0.f, 0.f, 0.f};
                if (ts <= tc) {
#pragma unroll
                    for (int ks = 0; ks < 2; ++ks) { const bf16x8 kf = *(const LAS bf16x8*)(L + G_KT + (16 * ts + l15) * GP + (8 * g + 32 * ks) * 2);
                        const bf16x8 qf = *(const LAS bf16x8*)(L + G_QT + (16 * tc + l15) * GP + (8 * g + 32 * ks) * 2); a = mfma16(kf, qf, a); } }
                const int c = 16 * tc + l15;
#pragma unroll
                for (int r = 0; r < 4; ++r) a[r] = (16 * ts + 4 * g + r <= c) ? a[r] : 0.f;
                u32x2 wv; wv.x = pk2(a[0], a[1]); wv.y = pk2(a[2], a[3]);
                *(LAS u32x2*)(L + G_AM + c * GP + (16 * ts + 4 * g) * 2) = wv; }
            __syncthreads();
            { const int vt = w & 3, chh = w >> 2; const LAS float* COL = (const LAS float*)(L + G_QH);
              bf16x8 Vf[2], Sb[2];
#pragma unroll
              for (int ks = 0; ks < 2; ++ks) { const LAS unsigned char* pa = L + G_VS + (32 * ks + 8 * g + r4) * GP + (16 * vt + 4 * c4) * 2;
                  Vf[ks] = cat8(tr_read(pa), tr_read(pa + 4 * GP));
                  const f32x4 c0 = *(const LAS f32x4*)(COL + 32 * ks + 4 * g), c1 = *(const LAS f32x4*)(COL + 32 * ks + 16 + 4 * g);
                  Sb[ks] = pack8(S[2 * ks] * c0, S[2 * ks + 1] * c1); }
#pragma unroll
              for (int i = 0; i < 2; ++i) { const int tc = 2 * chh + i, c = 16 * tc + l15;
                  f32x4 o = (f32x4){0.f, 0.f, 0.f, 0.f};
#pragma unroll
                  for (int ks = 0; ks < 2; ++ks) { const u32x2 q0 = *(const LAS u32x2*)(L + G_QT + c * GP + (32 * ks + 4 * g) * 2), q1 = *(const LAS u32x2*)(L + G_QT + c * GP + (32 * ks + 16 + 4 * g) * 2);
                      o = mfma16(__builtin_bit_cast(bf16x8, ((u32x4){q0.x, q0.y, q1.x, q1.y})), Sb[ks], o); }
#pragma unroll
                  for (int ks = 0; ks < 2; ++ks) if (32 * ks <= 16 * tc + 15) { const bf16x8 am = *(const LAS bf16x8*)(L + G_AM + c * GP + (32 * ks + 8 * g) * 2); o = mfma16(am, Vf[ks], o); }
#pragma unroll
                  for (int r = 0; r < 4; ++r) *(LAS bf16*)(L + G_OB + (16 * tc + 4 * g + r) * GP + (16 * vt + l15) * 2) = (bf16)f2bf(o[r]); }
#pragma unroll
              for (int dt = 0; dt < 4; ++dt) { f32x4 T = (f32x4){0.f, 0.f, 0.f, 0.f};
#pragma unroll
                  for (int ks = 0; ks < 2; ++ks) { const LAS unsigned char* pa = L + G_KT + (32 * ks + 8 * g + r4) * GP + (16 * dt + 4 * c4) * 2;
                      T = mfma16(cat8(tr_read(pa), tr_read(pa + 4 * GP)), Vf[ks], T); }
                  const f32x4 ck = *(const LAS f32x4*)(COL + 64 + 16 * dt + 4 * g), dc = *(const LAS f32x4*)(COL + 128 + 16 * dt + 4 * g);
                  S[dt] = S[dt] * dc + T * ck; } }
            __syncthreads();
        }
        { const u32x4 ov = *(const LAS u32x4*)(L + G_OB + sv * GP + c8 * 16);
          *(u32x4*)(Obuf + (size_t)dir * TT * 512 + (size_t)(prev_rowbase + svpos) * 512 + 128 * h + 64 * vh + 8 * c8) = ov; }
        __syncthreads();
#undef GLA_ROWBASE
    }
}
__device__ __forceinline__ void gla_combine(Frame& F, int layer) {
    const int gw = F.vcu * NWAVES + F.wave; const bf16* proj = (const bf16*)(F.ws + WS_BIG); const bf16* Of = (const bf16*)(F.ws + WS_O); const bf16* Ob = Of + (size_t)TT * 512;
    bf16* Hc = (bf16*)(F.ws + WS_H);
    float gn[8];
#pragma unroll
    for (int i = 0; i < 8; ++i) gn[i] = F.inp(I_GGN)[layer * 128 + ((8 * F.lane) & 127) + i];
    const int nseg = layer == 0 ? 2 : 1;
    for (int seg = 0; seg < nseg; ++seg) { const int r0 = seg ? TL + 2 * gw : 32 * gw, nr = seg ? 2 : 32;
        u32x4 an = *(const u32x4*)(Of + (size_t)r0 * 512 + 8 * F.lane), bn = *(const u32x4*)(Ob + (size_t)r0 * 512 + 8 * F.lane), rn = *(const u32x4*)(proj + (size_t)r0 * PP + C_GR + 8 * F.lane);
        for (int i = 0; i < nr; ++i) { const int row = r0 + i;
            const u32x4 a = an, b = bn, r = rn;
            if (i + 1 < nr) { an = *(const u32x4*)(Of + (size_t)(row + 1) * 512 + 8 * F.lane); bn = *(const u32x4*)(Ob + (size_t)(row + 1) * 512 + 8 * F.lane); rn = *(const u32x4*)(proj + (size_t)(row + 1) * PP + C_GR + 8 * F.lane); }
            float o[8], rr[8];
            o[0] = bflo(a.x) + bflo(b.x); o[1] = bfhi(a.x) + bfhi(b.x); o[2] = bflo(a.y) + bflo(b.y); o[3] = bfhi(a.y) + bfhi(b.y); o[4] = bflo(a.z) + bflo(b.z); o[5] = bfhi(a.z) + bfhi(b.z); o[6] = bflo(a.w) + bflo(b.w); o[7] = bfhi(a.w) + bfhi(b.w);
            rr[0] = bflo(r.x); rr[1] = bfhi(r.x); rr[2] = bflo(r.y); rr[3] = bfhi(r.y); rr[4] = bflo(r.z); rr[5] = bfhi(r.z); rr[6] = bflo(r.w); rr[7] = bfhi(r.w);
            float ss = 0.f;
#pragma unroll
            for (int q = 0; q < 8; ++q) ss += o[q] * o[q];
            ss = red_row16<OpAdd>(ss);
            const float ri = 1.0f / sqrtf(ss * (1.0f / 128.0f) + EPS);
            float v[8];
#pragma unroll
            for (int q = 0; q < 8; ++q) v[q] = (o[q] * ri * gn[q]) * (rr[q] / (1.0f + __expf(-rr[q])));
            *(u32x4*)(Hc + (size_t)row * D + 8 * F.lane) = (u32x4){pk2(v[0], v[1]), pk2(v[2], v[3]), pk2(v[4], v[5]), pk2(v[6], v[7])}; } }
}

constexpr int NA_CK = 0, NA_CV = 36864;
constexpr int NA_RK = 0, NA_RV = 63360, NA_RPB = 126720;
constexpr float NA_SC = 0.125f * 1.44269504f;
struct NaSt { float m, l; f32x4 OT[4]; };
__device__ __forceinline__ int na_sw(int row, int c) { return row * 144 + (c << 4); }
__device__ __forceinline__ void na_softmax(NaSt& st, f32x4 (&s)[4], bf16x8 (&pf)[2]) {
    float mx = fmaxf(fmaxf(fmaxf(s[0][0], s[0][1]), fmaxf(s[0][2], s[0][3])), fmaxf(fmaxf(s[1][0], s[1][1]), fmaxf(s[1][2], s[1][3])));
    mx = fmaxf(mx, fmaxf(fmaxf(fmaxf(s[2][0], s[2][1]), fmaxf(s[2][2], s[2][3])), fmaxf(fmaxf(s[3][0], s[3][1]), fmaxf(s[3][2], s[3][3]))));
    mx = red_x32<OpMax>(red_x16<OpMax>(mx));
    const float mnew = fmaxf(st.m, mx), alpha = __builtin_amdgcn_exp2f(st.m - mnew);
    float ps = 0.f;
#pragma unroll
    for (int i = 0; i < 4; ++i)
#pragma unroll
        for (int r = 0; r < 4; ++r) { const float pv = __builtin_amdgcn_exp2f(s[i][r] - mnew); s[i][r] = pv; ps += pv; }
    st.l = st.l * alpha + ps; st.m = mnew;
#pragma unroll
    for (int dt = 0; dt < 4; ++dt) st.OT[dt] *= alpha;
    pf[0] = pack8(s[0], s[1]); pf[1] = pack8(s[2], s[3]);
}
__device__ __forceinline__ void na_ctx_chunks(NaSt& st, const LAS unsigned char* L, int g, int l15, int r4, int c4, const bf16x8 (&qf)[2]) {
#pragma unroll 1
    for (int cc = 0; cc < 4; ++cc) {
        f32x4 s[4]; bf16x8 pf[2];
#pragma unroll
        for (int i = 0; i < 4; ++i) { const int key = 16 * (4 * cc + i) + l15;
            const bf16x8 k0 = *(const LAS bf16x8*)(L + NA_CK + na_sw(key, g)), k1 = *(const LAS bf16x8*)(L + NA_CK + na_sw(key, g + 4));
            f32x4 a = mfma16(k0, qf[0], (f32x4){0.f, 0.f, 0.f, 0.f}); a = mfma16(k1, qf[1], a); s[i] = a * NA_SC; }
        na_softmax(st, s, pf);
#pragma unroll
        for (int kk = 0; kk < 2; ++kk) { const int key = 16 * (4 * cc + 2 * kk) + 4 * g + r4;
#pragma unroll
            for (int dt = 0; dt < 4; ++dt) {
                const LAS unsigned char* pa = L + NA_CV + na_sw(key, 2 * dt + (c4 >> 1)) + (c4 & 1) * 8;
                const LAS unsigned char* pb = L + NA_CV + na_sw(key + 16, 2 * dt + (c4 >> 1)) + (c4 & 1) * 8;
                st.OT[dt] = mfma16(cat8(tr_read(pa), tr_read(pb)), pf[kk], st.OT[dt]); } }
    }
}
__device__ __forceinline__ void na_finish(NaSt& st, bf16* dst  , int g) {
    float l = red_x32<OpAdd>(red_x16<OpAdd>(st.l));
    const float inv = 1.0f / l;
#pragma unroll
    for (int dt = 0; dt < 4; ++dt) { u32x2 wv; wv.x = pk2(st.OT[dt][0] * inv, st.OT[dt][1] * inv); wv.y = pk2(st.OT[dt][2] * inv, st.OT[dt][3] * inv); *(u32x2*)(dst + 16 * dt + 4 * g) = wv; }
}
__device__ __forceinline__ void na_phase(Frame& F, int layer) {
    const bf16* proj = (const bf16*)(F.ws + WS_BIG); bf16* Hc = (bf16*)(F.ws + WS_H);
    LAS unsigned char* L = F.lds; LAS float* RPB = (LAS float*)(L + NA_RPB);
    const int t = F.tid, lane = F.lane, w = F.wave, g = lane >> 4, l15 = lane & 15, r4 = l15 >> 2, c4 = l15 & 3;
    for (int task = F.vcu; task < 256; task += F.G) {
        const int ch = task & 1, h = (task >> 1) & 7, b = task >> 4, kc0 = ch ? 24 : 0;
        const int jb = 2 * ch + (w & 1), c = 16 * jb + l15;
        unsigned* part = (unsigned*)(F.ws + WS_NAPART) + (size_t)task * 128 * 640;
        const bf16* qbase = proj + (size_t)(b * 4096 + c) * PP + C_NQ + 64 * h + 8 * g;
        for (int q = t; q < 4096; q += 512) { const int tensor = q >> 11, key = (q >> 3) & 255, cc8 = q & 7;
            const u32x4 v = *(const u32x4*)(proj + (size_t)(TL + b * 256 + key) * PP + (tensor ? C_NV : C_NK) + 64 * h + 8 * cc8);
            *(LAS u32x4*)(L + (tensor ? NA_CV : NA_CK) + na_sw(key, cc8)) = v; }
        __syncthreads();
        if (layer == 0) {
            const int tok = TL + b * 256 + 128 * ch + 16 * w + l15;
            bf16x8 qf[2];
            { const bf16* qp = proj + (size_t)tok * PP + C_NQ + 64 * h + 8 * g; qf[0] = *(const bf16x8*)qp; qf[1] = *(const bf16x8*)(qp + 32); }
            NaSt st; st.m = -1.0e30f; st.l = 0.f;
#pragma unroll
            for (int dt = 0; dt < 4; ++dt) st.OT[dt] = (f32x4){0.f, 0.f, 0.f, 0.f};
            na_ctx_chunks(st, L, g, l15, r4, c4, qf);
            na_finish(st, Hc + (size_t)tok * D + 512 + 64 * h, g);
        }
        {
            bf16x8 qn[2];
            { const bf16* qp = qbase + (size_t)((w >> 1) * 64) * PP; qn[0] = *(const bf16x8*)qp; qn[1] = *(const bf16x8*)(qp + 32); }
#pragma unroll 1
            for (int i = 0; i < 16; ++i) {
                bf16x8 qf[2]; qf[0] = qn[0]; qf[1] = qn[1];
                if (i + 1 < 16) { const bf16* qp = qbase + (size_t)((4 * (i + 1) + (w >> 1)) * 64) * PP; qn[0] = *(const bf16x8*)qp; qn[1] = *(const bf16x8*)(qp + 32); }
                NaSt st; st.m = -1.0e30f; st.l = 0.f;
#pragma unroll
                for (int dt = 0; dt < 4; ++dt) st.OT[dt] = (f32x4){0.f, 0.f, 0.f, 0.f};
                na_ctx_chunks(st, L, g, l15, r4, c4, qf);
                unsigned* pr = part + (size_t)(8 * i + w) * 640 + lane;
                pr[0] = __builtin_bit_cast(unsigned, st.m); pr[64] = __builtin_bit_cast(unsigned, st.l);
#pragma unroll
                for (int dt = 0; dt < 4; ++dt) { pr[64 * (2 + 2 * dt)] = pk2(st.OT[dt][0], st.OT[dt][1]); pr[64 * (3 + 2 * dt)] = pk2(st.OT[dt][2], st.OT[dt][3]); }
            }
        }
        __syncthreads();
        for (int q = t; q < 8 * 640; q += 512) { const int row = q / 640, rem = q - row * 640, tensor = rem / 320, r2 = rem - tensor * 320, key = r2 >> 3, cc8 = r2 & 7;
            const u32x4 v = *(const u32x4*)(proj + (size_t)(b * 4096 + row * 64 + kc0 + key) * PP + (tensor ? C_NV : C_NK) + 64 * h + 8 * cc8);
            *(LAS u32x4*)(L + (tensor ? NA_RV : NA_RK) + na_sw((row % 11) * 40 + key, cc8)) = v; }
        for (int i = t; i < 465; i += 512) RPB[i] = F.inp(I_RPB)[(size_t)(layer * 8 + h) * 465 + i] * 1.44269504f;
        int have = 7;
        __syncthreads();
        const int kl0 = (jb & 1) ? 8 : 0, lo = kc0 + kl0, cs = min(max(c - 8, 0), 48);
        bf16x8 qn[2]; unsigned pn[10];
        { const bf16* qp = qbase + (size_t)((w >> 1) * 64) * PP; qn[0] = *(const bf16x8*)qp; qn[1] = *(const bf16x8*)(qp + 32);
          const unsigned* pr = part + (size_t)w * 640 + lane;
#pragma unroll
          for (int j = 0; j < 10; ++j) pn[j] = pr[64 * j]; }
#pragma unroll 1
        for (int st_ = 0; st_ < 16; ++st_) {
            const int qrow = 4 * st_ + (w >> 1), tok = b * 4096 + qrow * 64 + c;
            bf16x8 qf[2]; qf[0] = qn[0]; qf[1] = qn[1];
            NaSt st; st.m = __builtin_bit_cast(float, pn[0]); st.l = __builtin_bit_cast(float, pn[1]);
#pragma unroll
            for (int dt = 0; dt < 4; ++dt) st.OT[dt] = (f32x4){bflo(pn[2 + 2 * dt]), bfhi(pn[2 + 2 * dt]), bflo(pn[3 + 2 * dt]), bfhi(pn[3 + 2 * dt])};
            u32x4 pre[5]; int nnew = 0;
            if (st_ + 1 < 16) {
                const int hin = min(max(4 * (st_ + 1) - 1, 0), 56) + 7; nnew = hin - have;
#pragma unroll
                for (int j = 0; j < 5; ++j) { const int q = t + 512 * j;
                    if (q < nnew * 640) { const int ri = q / 640, rem = q - ri * 640, tensor = rem / 320, r2 = rem - tensor * 320, key = r2 >> 3, cc8 = r2 & 7;
                        pre[j] = *(const u32x4*)(proj + (size_t)(b * 4096 + (have + 1 + ri) * 64 + kc0 + key) * PP + (tensor ? C_NV : C_NK) + 64 * h + 8 * cc8); } }
                const bf16* qp = qbase + (size_t)((qrow + 4) * 64) * PP; qn[0] = *(const bf16x8*)qp; qn[1] = *(const bf16x8*)(qp + 32);
                const unsigned* pr = part + (size_t)(8 * (st_ + 1) + w) * 640 + lane;
#pragma unroll
                for (int j = 0; j < 10; ++j) pn[j] = pr[64 * j];
            }
            const int rs = min(max(qrow - 4, 0), 56);
#pragma unroll 1
            for (int lc = 0; lc < 4; ++lc) {
                f32x4 s[4]; bf16x8 pf[2];
#pragma unroll
                for (int kk = 0; kk < 2; ++kk) { const int i = 2 * lc + kk, slot = (rs + i) % 11, roff = rs + i - qrow + 7;
#pragma unroll
                    for (int hf = 0; hf < 2; ++hf) { const int kidx = slot * 40 + kl0 + 16 * hf + l15;
                        const bf16x8 k0 = *(const LAS bf16x8*)(L + NA_RK + na_sw(kidx, g)), k1 = *(const LAS bf16x8*)(L + NA_RK + na_sw(kidx, g + 4));
                        f32x4 a = mfma16(k0, qf[0], (f32x4){0.f, 0.f, 0.f, 0.f}); a = mfma16(k1, qf[1], a);
#pragma unroll
                        for (int r = 0; r < 4; ++r) { const int kc = lo + 16 * hf + 4 * g + r; const bool valid = (kc >= cs) && (kc < cs + 16);
                            const int coff = min(max(kc - c + 15, 0), 30);
                            a[r] = valid ? a[r] * NA_SC + RPB[roff * 31 + coff] : -1.0e30f; }
                        s[2 * kk + hf] = a; } }
                na_softmax(st, s, pf);
#pragma unroll
                for (int kk = 0; kk < 2; ++kk) { const int slot = (rs + 2 * lc + kk) % 11, kidx = slot * 40 + kl0 + 4 * g + r4;
#pragma unroll
                    for (int dt = 0; dt < 4; ++dt) {
                        const LAS unsigned char* pa = L + NA_RV + na_sw(kidx, 2 * dt + (c4 >> 1)) + (c4 & 1) * 8;
                        const LAS unsigned char* pb = L + NA_RV + na_sw(kidx + 16, 2 * dt + (c4 >> 1)) + (c4 & 1) * 8;
                        st.OT[dt] = mfma16(cat8(tr_read(pa), tr_read(pb)), pf[kk], st.OT[dt]); } }
            }
            na_finish(st, Hc + (size_t)tok * D + 512 + 64 * h, g);
            __syncthreads();
            if (nnew > 0) {
#pragma unroll
                for (int j = 0; j < 5; ++j) { const int q = t + 512 * j;
                    if (q < nnew * 640) { const int ri = q / 640, rem = q - ri * 640, tensor = rem / 320, r2 = rem - tensor * 320, key = r2 >> 3, cc8 = r2 & 7;
                        *(LAS u32x4*)(L + (tensor ? NA_RV : NA_RK) + na_sw(((have + 1 + ri) % 11) * 40 + key, cc8)) = pre[j]; } }
                have += nnew;
            }
            __syncthreads();
        }
    }
}


#ifndef REP_P0
#define REP_P0 1
#endif
#ifndef REP_GLA
#define REP_GLA 1
#endif
#ifndef REP_NA
#define REP_NA 1
#endif
#ifndef REP_GEMM
#define REP_GEMM 1
#endif
#ifdef NO_P0
#define PH_P0(x)
#else
#define PH_P0(x) for (int rep_ = 0; rep_ < REP_P0; ++rep_) { x __syncthreads(); }
#endif
#ifdef NO_T
#define PH_T(x)
#else
#define PH_T(x) x
#endif
#ifdef NO_T2
#define PH_T2(x)
#else
#define PH_T2(x) x
#endif
#ifdef NO_GLA
#define PH_GLA(x)
#else
#define PH_GLA(x) for (int rep_ = 0; rep_ < REP_GLA; ++rep_) { x }
#endif
#ifdef NO_NA
#define PH_NA(x)
#else
#define PH_NA(x) for (int rep_ = 0; rep_ < REP_NA; ++rep_) { x }
#endif
#ifdef NO_GEMM
#define PH_GEMM if (0)
#else
#define PH_GEMM _Pragma("unroll 1") for (int rep_ = 0; rep_ < REP_GEMM; ++rep_)
#endif
#define IN(k) (lo <= (k) && (k) < hi)
#define SEAM(k) do { if (IN(k) && IN((k) + 1)) xcd_barrier(bar); } while (0)
template <int L> __device__ __forceinline__ void layer_phases(Frame& F, const XcdBarrier& bar, const int lo, const int hi) {
    constexpr int l = L; constexpr int pb = 2 + 8 * l;
    bf16* Hb = (bf16*)(F.ws + WS_H); bf16* BIG = (bf16*)(F.ws + WS_BIG);
        if (IN(pb + 0)) { pg8::Gemm g{Hb, (const bf16*)(F.ws + WS_WIN + (size_t)l * PP * D), TT, PP, D / 2, nullptr, 0}; pg8::StaticOrder S; S.init(TT, PP, F.G, (int)blockIdx.x);
            pg8::EpiBf16Q E{BIG, PP, (const float*)(F.ws + WS_SROW), (const float*)(F.ws + WS_SB_IN) + (size_t)l * PP, nullptr, 0, 0.f};
            PH_GEMM pg8::gemm_phase<pg8::EpiBf16Q, pg8::StaticOrder, true, false, 1>(F.lds + RING_OFF, g, S, E); }
        SEAM(pb + 0);
        if (IN(pb + 1)) { PH_GLA(gla_phase(F, l);) }
        SEAM(pb + 1);
        if (IN(pb + 2)) { PH_T(gla_combine(F, l);) PH_NA(na_phase(F, l);) }
        SEAM(pb + 2);
        if (IN(pb + 3)) { const int M = l == 0 ? TT : TL; pg8::Gemm g{Hb, (const bf16*)(F.ws + WS_WOUT) + (size_t)l * D * D, M, D, D, nullptr, 0}; pg8::StaticOrder S; S.init(M, D, F.G, (int)blockIdx.x);
            pg8::EpiBf16 E{BIG, D};
            PH_GEMM pg8::gemm_phase<pg8::EpiBf16, pg8::StaticOrder, true, false>(F.lds + RING_OFF, g, S, E); }
        SEAM(pb + 3);
        if (IN(pb + 4)) { PH_T2(t2_postmix(F, l);) }
        SEAM(pb + 4);
        if constexpr (l == 0) {
            if (IN(7)) { pg8::Gemm g{Hb, (const bf16*)(F.ws + WS_WGU0), TT, 2 * DFF, D / 2, nullptr, 0}; pg8::StaticOrder S; S.init(TT, 2 * DFF, F.G, (int)blockIdx.x);
                pg8::EpiSwiGLUQ8 E{(signed char*)BIG, DFF, (const float*)(F.ws + WS_SROW), (const float*)(F.ws + WS_SB_GU0), nullptr, 0, 127.0f / HID_RANGE};
                PH_GEMM pg8::gemm_phase<pg8::EpiSwiGLUQ8, pg8::StaticOrder, true, false, 1>(F.lds + RING_OFF, g, S, E); }
            SEAM(7);
            if (IN(8)) { pg8::Gemm g{BIG, (const bf16*)(F.ws + WS_WD0), TT, D, DFF / 2, nullptr, 0}; pg8::StaticOrder S; S.init(TT, D, F.G, (int)blockIdx.x);
                pg8::EpiBf16Q E{(bf16*)(F.ws + WS_O), D, nullptr, (const float*)(F.ws + WS_SB_D0), nullptr, 0, HID_RANGE / 127.0f};
                PH_GEMM pg8::gemm_phase<pg8::EpiBf16Q, pg8::StaticOrder, true, false, 1>(F.lds + RING_OFF, g, S, E); }
            SEAM(8);
            if (IN(9)) { PH_T(t3_postffn(F, 0);) }
            SEAM(9);
        }
    }
struct Args { const float* in[23]; float* out; unsigned char* ws; int ph_lo, ph_hi, li, pad; };
constexpr int NPHASE = 24;
__global__ void __launch_bounds__(NWAVES * 64, 2) fwd_kernel(Args args) {
    extern __shared__ __attribute__((aligned(16))) unsigned char lds[];
    Frame F;
    F.lds = (LAS unsigned char*)lds;
    F.tid = threadIdx.x; F.lane = F.tid & 63; F.wave = __builtin_amdgcn_readfirstlane(F.tid >> 6);
    F.G = gridDim.x; { const int bx = blockIdx.x; F.vcu = (F.G % 8 == 0) ? (bx % 8) * (F.G / 8) + bx / 8 : bx; }
    F.ws = args.ws; F.out = args.out;
    volatile LAS unsigned* MISC = (volatile LAS unsigned*)(F.lds + MISC_OFF);
    for (int u = F.tid; u < (LDS_BYTES - LDSCTL_OFF) / 4; u += NWAVES * 64) ((LAS unsigned*)(F.lds + LDSCTL_OFF))[u] = 0u;
    if (F.tid < 23) ((LAS unsigned long long*)(F.lds + PTAB_OFF))[F.tid] = (unsigned long long)args.in[F.tid];
    __syncthreads();
    unsigned* ctl = (unsigned*)(F.ws + WS_CTL);
    XcdBarrier bar = xcd_barrier_post(ctl + CW_BAR + args.li * XCD_BAR_WORDS, MISC + 8);
    const int lo = args.ph_lo, hi = args.ph_hi;

    if (IN(0)) { PH_P0(p0_prologue(F);) } SEAM(0);
    if (IN(1)) { PH_T(t1_prenorm(F);) } SEAM(1);

    layer_phases<0>(F, bar, lo, hi);
    layer_phases<1>(F, bar, lo, hi);
    if (IN(15)) { PH_T(m2_lists(F);) }
    SEAM(15);
    if (IN(16)) { PH_T(moe_gather(F);) }
    SEAM(16);
    for (int sl = 0; sl < MOE_NSL; ++sl) {
        const int pg = 17 + 2 * sl;
        if (IN(pg) || IN(pg + 1)) {
            const int ntiles = min(max(((const int*)(F.ws + WS_MOE + MOE_META))[0], 0), MOE_MAXT);
            const int t0 = sl * MOE_SLT, nts = min(max(ntiles - t0, 0), MOE_SLT);
            LAS int* texp = (LAS int*)(F.lds + IDX_OFF);
            if (nts > 0) { if (F.tid < MOE_SLT) texp[F.tid] = min(max(((const int*)(F.ws + WS_MOE + MOE_TEXP))[t0 + F.tid], 0), NE - 1); __syncthreads(); }
            if (IN(pg) && nts > 0) {
                pg8::StaticOrder S; S.init(nts * 256, 2 * DFE, F.G, (int)blockIdx.x);
                pg8::Gemm g{(const bf16*)(F.ws + WS_ASORT + (size_t)t0 * 256 * D), (const bf16*)(F.ws + WS_WGU1), nts * 256, 2 * DFE, D / 2, texp, (size_t)DFE * D};
                pg8::EpiSwiGLUQ8 E{(signed char*)(F.ws + WS_HIDS), DFE, (const float*)(F.ws + WS_SSORT) + (size_t)t0 * 256, (const float*)(F.ws + WS_SB_GU1), texp, 2 * DFE, 127.0f / HID_RANGE};
                PH_GEMM pg8::gemm_phase<pg8::EpiSwiGLUQ8, pg8::StaticOrder, true, true, 1>(F.lds + RING_OFF, g, S, E);
            }
            SEAM(pg);
            if (IN(pg + 1) && nts > 0) {
                pg8::StaticOrder S; S.init(nts * 256, D, F.G, (int)blockIdx.x);
                pg8::Gemm g{(const bf16*)(F.ws + WS_HIDS), (const bf16*)(F.ws + WS_WD1), nts * 256, D, DFE / 2, texp, (size_t)D * DFE / 2};
                pg8::EpiBf16Q E{(bf16*)(F.ws + WS_OUTP) + (size_t)t0 * 256 * D, D, nullptr, (const float*)(F.ws + WS_SB_D1), texp, D, HID_RANGE / 127.0f};
                PH_GEMM pg8::gemm_phase<pg8::EpiBf16Q, pg8::StaticOrder, true, true, 1>(F.lds + RING_OFF, g, S, E);
            }
            SEAM(pg + 1);
        } else { SEAM(pg); SEAM(pg + 1); }
    }
    if (IN(17 + 2 * MOE_NSL)) { PH_T(t3_postffn(F, 1);) }
}

#ifndef MK_LAUNCH_PER_PHASE
#define MK_LAUNCH_PER_PHASE 0
#endif
extern "C" void kernel_launch(void* const* d_in, const int* in_sizes, int n_in, void* d_out, int out_size, void* d_ws, size_t ws_size, hipStream_t stream) {
    static int grid = 0;
    if (grid == 0) {
        if (n_in != 23 || out_size != TL * D || ws_size < WS_END) { fprintf(stderr, "kernel_launch: unexpected shapes (n_in %d, out %d, ws %zu)\n", n_in, out_size, ws_size); grid = -1; return; }
        int dev = 0, cus = 0, per_cu = 0;
        if (hipGetDevice(&dev) != hipSuccess || hipDeviceGetAttribute(&cus, hipDeviceAttributeMultiprocessorCount, dev) != hipSuccess) { grid = -1; return; }
        if (hipFuncSetAttribute((const void*)fwd_kernel, hipFuncAttributeMaxDynamicSharedMemorySize, LDS_BYTES) != hipSuccess) { fprintf(stderr, "kernel_launch: hipFuncSetAttribute failed\n"); grid = -1; return; }
        if (hipOccupancyMaxActiveBlocksPerMultiprocessor(&per_cu, (const void*)fwd_kernel, NWAVES * 64, LDS_BYTES) != hipSuccess || per_cu < 1) fprintf(stderr, "kernel_launch: occupancy query reports %d\n", per_cu);
        (void)hipGetLastError();
        grid = 256;
        if (cus < 256) fprintf(stderr, "kernel_launch: device has %d CUs, this kernel needs 256\n", cus);
    }
    if (grid < 0) return;
    if (hipMemsetAsync((char*)d_ws + WS_CTL, 0, CTL_ZERO_BYTES, stream) != hipSuccess) return;
    Args a{};
    for (int i = 0; i < 23; ++i) a.in[i] = (const float*)d_in[i];
    a.out = (float*)d_out; a.ws = (unsigned char*)d_ws;
#if MK_LAUNCH_PER_PHASE
    for (int p = 0; p < NPHASE; ++p) { a.ph_lo = p; a.ph_hi = p + 1; a.li = 0; a.pad = 0;
        hipLaunchKernelGGL(fwd_kernel, dim3(grid), dim3(NWAVES * 64), LDS_BYTES, stream, a); }
#else
    a.ph_lo = 0; a.ph_hi = NPHASE; a.li = 0; a.pad = 0;
    hipLaunchKernelGGL(fwd_kernel, dim3(grid), dim3(NWAVES * 64), LDS_BYTES, stream, a);
#endif
}
```

```cpp
#include <hip/hip_runtime.h>
#include <cstdio>
#include <cstdint>

namespace pg8 {
#define PG8_LAS __attribute__((address_space(3)))
typedef unsigned short bf16_t;
typedef short bf16x8 __attribute__((ext_vector_type(8)));
typedef float f32x4 __attribute__((ext_vector_type(4)));
typedef unsigned u32x4 __attribute__((ext_vector_type(4)));
typedef unsigned u32x2 __attribute__((ext_vector_type(2)));
constexpr int BM = 256, BK = 64, HALF = 128, HTB = HALF * BK * 2, STAGE_BYTES = 8 * HTB, NXCD = 8, WGM = 8;

__host__ __device__ __forceinline__ int lds_byte(int r, int c) { const int st = (r >> 4) * 2 + (c >> 5), rr = r & 15, cc = c & 31, ob = rr * 64 + cc * 2; return st * 1024 + (ob ^ (((ob >> 9) & 1) << 5)); }
__host__ __device__ __forceinline__ void stage_rc(int b, int& R, int& C) { const int st = b / 1024, sb = b % 1024, swz = sb ^ (((sb >> 9) & 1) << 5); R = (st >> 1) * 16 + swz / 64; C = (st & 1) * 32 + (swz % 64) / 2; }
__host__ __device__ __forceinline__ int perm32(int rho) { const int n = rho >> 4, i = rho & 15; return 8 * (i >> 2) + 4 * n + (i & 3); }

struct Unit { int pm, pn; };
struct Gemm { const bf16_t* A; const bf16_t* Bt; int M, N, K; const PG8_LAS int* texp; size_t estride; };

struct StaticOrder {
    int nM, nN, nwg, G, c;
    __host__ __device__ void init(int M, int N, int G_, int c_) { nM = M / BM; nN = N / BM; nwg = nM * nN; G = G_; c = c_; }
    __host__ __device__ bool next(int i, Unit& u) const {
        const long L = (long)i * G + c; if (L >= nwg) return false;
        int wgid = (int)L; { const int q = nwg / NXCD, r = nwg % NXCD, xcd = wgid % NXCD, off = wgid / NXCD; wgid = (xcd < r ? xcd * (q + 1) : r * (q + 1) + (xcd - r) * q) + off; }
        const int nig = WGM * nN, gid = wgid / nig, fm = gid * WGM, gsz = (nM - fm) < WGM ? (nM - fm) : WGM;
        u.pm = fm + ((wgid % nig) % gsz); u.pn = (wgid % nig) / gsz; return true;
    }
};

__device__ __forceinline__ unsigned cvt_pk_bf16(float lo, float hi) { unsigned r; asm volatile("v_cvt_pk_bf16_f32 %0, %1, %2" : "=v"(r) : "v"(lo), "v"(hi)); return r; }

struct EpiBf16 {
    static constexpr bool PERM = true;
    bf16_t* O; int ldc;
    __device__ __forceinline__ void operator()(const f32x4 (&acc)[2][2][4][2], const Unit& u, int wr, int wc, int fr, int fq) const {
        const int row0 = u.pm * BM + wr * 64 + fr; const int col0 = u.pn * BM + wc * 32 + 8 * fq;
#pragma unroll
        for (int ai = 0; ai < 2; ++ai)
#pragma unroll
            for (int m = 0; m < 4; ++m) { bf16_t* rowp = O + (size_t)(row0 + ai * HALF + m * 16) * ldc + col0;
#pragma unroll
                for (int bj = 0; bj < 2; ++bj) { const f32x4 v0 = acc[ai][bj][m][0], v1 = acc[ai][bj][m][1];
                    u32x4 w; w.x = cvt_pk_bf16(v0[0], v0[1]); w.y = cvt_pk_bf16(v0[2], v0[3]); w.z = cvt_pk_bf16(v1[0], v1[1]); w.w = cvt_pk_bf16(v1[2], v1[3]);
                    *(u32x4*)(rowp + bj * HALF) = w; } }
    }
};
__device__ __forceinline__ float silu_f(float g) { return g * __builtin_amdgcn_rcpf(1.0f + __builtin_amdgcn_exp2f(-1.44269504f * g)); }

typedef int i32x4 __attribute__((ext_vector_type(4)));
template <int MODE> struct AccT { typedef f32x4 type; };
template <> struct AccT<1> { typedef i32x4 type; };
template <int MODE> __device__ __forceinline__ typename AccT<MODE>::type mma_pair(const bf16x8 (&b)[2], const bf16x8 (&a)[2], typename AccT<MODE>::type c) {
    if constexpr (MODE == 1) { c = __builtin_amdgcn_mfma_i32_16x16x64_i8(__builtin_bit_cast(i32x4, b[0]), __builtin_bit_cast(i32x4, a[0]), c, 0, 0, 0);
        return __builtin_amdgcn_mfma_i32_16x16x64_i8(__builtin_bit_cast(i32x4, b[1]), __builtin_bit_cast(i32x4, a[1]), c, 0, 0, 0); }
    else { c = __builtin_amdgcn_mfma_f32_16x16x32_bf16(b[0], a[0], c, 0, 0, 0); return __builtin_amdgcn_mfma_f32_16x16x32_bf16(b[1], a[1], c, 0, 0, 0); }
}
struct EpiBf16Q {
    static constexpr bool PERM = true;
    bf16_t* O; int ldc; const float* sa; const float* sb; const PG8_LAS int* texp; int sbstride; float sconst;
    __device__ __forceinline__ void operator()(const i32x4 (&acc)[2][2][4][2], const Unit& u, int wr, int wc, int fr, int fq) const {
        const int row0 = u.pm * BM + wr * 64 + fr; const int col0 = u.pn * BM + wc * 32 + 8 * fq;
        const float* sbe = sb + (texp ? (size_t)__builtin_amdgcn_readfirstlane(texp[u.pm]) * sbstride : (size_t)0);
        f32x4 cb[2][2];
#pragma unroll
        for (int bj = 0; bj < 2; ++bj) { cb[bj][0] = *(const f32x4*)(sbe + col0 + bj * HALF); cb[bj][1] = *(const f32x4*)(sbe + col0 + bj * HALF + 4); }
#pragma unroll
        for (int ai = 0; ai < 2; ++ai)
#pragma unroll
            for (int m = 0; m < 4; ++m) { const int row = row0 + ai * HALF + m * 16; const float ra = sa ? sa[row] : sconst; bf16_t* rowp = O + (size_t)row * ldc + col0;
#pragma unroll
                for (int bj = 0; bj < 2; ++bj) { const i32x4 a0 = acc[ai][bj][m][0], a1 = acc[ai][bj][m][1];
                    const f32x4 v0 = (f32x4){(float)a0[0], (float)a0[1], (float)a0[2], (float)a0[3]} * cb[bj][0] * ra, v1 = (f32x4){(float)a1[0], (float)a1[1], (float)a1[2], (float)a1[3]} * cb[bj][1] * ra;
                    u32x4 w; w.x = cvt_pk_bf16(v0[0], v0[1]); w.y = cvt_pk_bf16(v0[2], v0[3]); w.z = cvt_pk_bf16(v1[0], v1[1]); w.w = cvt_pk_bf16(v1[2], v1[3]);
                    *(u32x4*)(rowp + bj * HALF) = w; } }
    }
};
struct EpiSwiGLUQ8 {
    static constexpr bool PERM = false;
    signed char* Hd8; int ldh; const float* sa; const float* sb; const PG8_LAS int* texp; int sbstride; float hinv;
    __device__ __forceinline__ void operator()(const i32x4 (&acc)[2][2][4][2], const Unit& u, int wr, int wc, int fr, int fq) const {
        const int row0 = u.pm * BM + wr * 64 + fr;
        const float* sbe = sb + (texp ? (size_t)__builtin_amdgcn_readfirstlane(texp[u.pm]) * sbstride : (size_t)0) + u.pn * BM + wc * 32 + 4 * fq;
        f32x4 cg[2], cu[2];
#pragma unroll
        for (int bj = 0; bj < 2; ++bj) { cg[bj] = *(const f32x4*)(sbe + bj * HALF); cu[bj] = *(const f32x4*)(sbe + bj * HALF + 16); }
#pragma unroll
        for (int ai = 0; ai < 2; ++ai)
#pragma unroll
            for (int m = 0; m < 4; ++m) { const int row = row0 + ai * HALF + m * 16; const float ra = sa[row]; signed char* rowp = Hd8 + (size_t)row * ldh;
#pragma unroll
                for (int bj = 0; bj < 2; ++bj) { const i32x4 gi = acc[ai][bj][m][0], ui = acc[ai][bj][m][1];
                    const f32x4 g = (f32x4){(float)gi[0], (float)gi[1], (float)gi[2], (float)gi[3]} * cg[bj] * ra, up = (f32x4){(float)ui[0], (float)ui[1], (float)ui[2], (float)ui[3]} * cu[bj] * (ra * hinv);
                    const int hc = 16 * (8 * u.pn + 4 * bj + wc) + 4 * fq;
                    unsigned w = 0u;
#pragma unroll
                    for (int e = 0; e < 4; ++e) { const float q = fminf(fmaxf(__builtin_rintf(silu_f(g[e]) * up[e]), -127.0f), 127.0f); w |= ((unsigned)(int)q & 255u) << (8 * e); }
                    *(unsigned*)(rowp + hc) = w; } }
    }
};

template <class Epi, class Sched, bool ALIGN_EPI, bool EXPERT, int MODE = 0  >
__device__ __forceinline__ void gemm_phase(PG8_LAS unsigned char* lds, const Gemm g, const Sched& S, const Epi& E) {
    const int tid = threadIdx.x, wid = __builtin_amdgcn_readfirstlane(tid >> 6), lane = tid & 63, wr = wid >> 2, wc = wid & 3, fr = lane & 15, fq = lane >> 4;
    const int K = g.K, nt = K / BK;
    unsigned voffA[2], voffB[2];
#pragma unroll
    for (int i = 0; i < 2; ++i) { int R, C; stage_rc(tid * 16 + i * 8192, R, C); const int Rb = Epi::PERM ? ((R & ~31) + perm32(R & 31)) : R;
        voffA[i] = (unsigned)(R * K + C) * 2u; voffB[i] = (unsigned)(Rb * K + C) * 2u; }
    const size_t kstep = (size_t)(BK * 2);
    const size_t hstep = (size_t)HALF * K * 2;
    const size_t tstep = 2 * hstep;
    const unsigned ldsw = (unsigned)wid * 1024u;
    const int aoff = lds_byte(wr * 64 + fr, fq * 8), boff = lds_byte(wc * 32 + fr, fq * 8);
#define PG8_SA(b, h) (((b) * 2 + (h)) * HTB)
#define PG8_SB(b, h) ((4 + (b) * 2 + (h)) * HTB)
#define PG8_STAGE(bufoff, gbase, voff) do { _Pragma("unroll") for (int _i = 0; _i < 2; ++_i) \
        __builtin_amdgcn_global_load_lds((const unsigned*)((const char*)(gbase) + (voff)[_i]), (PG8_LAS unsigned*)(lds + (bufoff) + ldsw + _i * 8192), 16, 0, 0); } while (0)
#define PG8_LDA(dst, b, h) do { _Pragma("unroll") for (int m = 0; m < 4; ++m) _Pragma("unroll") for (int k = 0; k < 2; ++k) dst[m][k] = *(const PG8_LAS bf16x8*)(lds + PG8_SA(b, h) + aoff + m * 2048 + k * 1024); } while (0)
#define PG8_LDB(dst, b, h) do { _Pragma("unroll") for (int n = 0; n < 2; ++n) _Pragma("unroll") for (int k = 0; k < 2; ++k) dst[n][k] = *(const PG8_LAS bf16x8*)(lds + PG8_SB(b, h) + boff + n * 2048 + k * 1024); } while (0)
#define PG8_MMA(ai, bj, At, Bt) do { __builtin_amdgcn_s_setprio(1); _Pragma("unroll") for (int m = 0; m < 4; ++m) _Pragma("unroll") for (int n = 0; n < 2; ++n) \
        acc[ai][bj][m][n] = mma_pair<MODE>(Bt[n], At[m], acc[ai][bj][m][n]); __builtin_amdgcn_s_setprio(0); } while (0)
#define PG8_WAIT_V(n) asm volatile("s_waitcnt vmcnt(" #n ")" ::: "memory")
#define PG8_WAIT_L(n) asm volatile("s_waitcnt lgkmcnt(" #n ")" ::: "memory")
#define PG8_BAR __builtin_amdgcn_s_barrier()
#define PG8_SCHED __builtin_amdgcn_sched_barrier(0)
#define PG8_BPTR(u) ((const char*)g.Bt + (EXPERT ? (size_t)__builtin_amdgcn_readfirstlane(g.texp[(u).pm]) * g.estride * 2 : (size_t)0) + (size_t)(u).pn * tstep)
    Unit cur, nxt; int ui = 0;
    if (!S.next(0, cur)) return;
    typedef typename AccT<MODE>::type acc_t;
    acc_t acc[2][2][4][2];
#pragma unroll
    for (int a = 0; a < 2; ++a)
#pragma unroll
        for (int b = 0; b < 2; ++b)
#pragma unroll
            for (int m = 0; m < 4; ++m)
#pragma unroll
                for (int n = 0; n < 2; ++n) acc[a][b][m][n] = acc_t{};
    bf16x8 At[4][2], B0[2][2], B1[2][2];
    const char* cA = (const char*)g.A + (size_t)cur.pm * tstep; const char* cB = PG8_BPTR(cur);
    PG8_STAGE(PG8_SB(0, 0), cB, voffB); PG8_STAGE(PG8_SB(0, 1), cB + hstep, voffB); PG8_STAGE(PG8_SA(0, 0), cA, voffA); PG8_STAGE(PG8_SA(0, 1), cA + hstep, voffA);
    if (wr == 1) PG8_BAR;
    PG8_WAIT_V(2); PG8_BAR;
    PG8_STAGE(PG8_SB(1, 0), cB + kstep, voffB); PG8_STAGE(PG8_SA(1, 0), cA + kstep, voffA); PG8_STAGE(PG8_SB(1, 1), cB + hstep + kstep, voffB);
    PG8_WAIT_V(6); PG8_BAR;
    for (;;) {
        const bool has_next = S.next(ui + 1, nxt);
        const char* nA = has_next ? (const char*)g.A + (size_t)nxt.pm * tstep : cA; const char* nB = has_next ? PG8_BPTR(nxt) : cB;
        for (int t = 0; t < nt; t += 2) {
            const bool last = (t == nt - 2);
            const char* a1 = cA + (size_t)(t + 1) * kstep;
            const char* a2 = last ? nA : cA + (size_t)(t + 2) * kstep; const char* b2 = last ? nB : cB + (size_t)(t + 2) * kstep;
            const char* a3 = a2 + kstep; const char* b3 = b2 + kstep;
            PG8_LDB(B0, 0, 0); PG8_LDB(B1, 0, 1); PG8_SCHED; PG8_LDA(At, 0, 0); PG8_STAGE(PG8_SA(1, 1), a1 + hstep, voffA);
            PG8_WAIT_V(8); PG8_WAIT_L(0); PG8_BAR; PG8_MMA(0, 0, At, B0); PG8_MMA(0, 1, At, B1); PG8_BAR; PG8_SCHED;
            PG8_LDA(At, 0, 1); PG8_STAGE(PG8_SB(0, 0), b2, voffB); PG8_STAGE(PG8_SB(0, 1), b2 + hstep, voffB); PG8_STAGE(PG8_SA(0, 0), a2, voffA);
            PG8_WAIT_V(8); PG8_WAIT_L(0); PG8_BAR; PG8_MMA(1, 0, At, B0); PG8_MMA(1, 1, At, B1); PG8_BAR; PG8_SCHED;
            PG8_LDB(B0, 1, 0); PG8_LDB(B1, 1, 1); PG8_SCHED; PG8_LDA(At, 1, 0); PG8_STAGE(PG8_SA(0, 1), a2 + hstep, voffA);
            PG8_WAIT_V(8); PG8_WAIT_L(0); PG8_BAR; PG8_MMA(0, 0, At, B0); PG8_MMA(0, 1, At, B1); PG8_BAR; PG8_SCHED;
            PG8_LDA(At, 1, 1); PG8_STAGE(PG8_SB(1, 0), b3, voffB); PG8_STAGE(PG8_SB(1, 1), b3 + hstep, voffB); PG8_STAGE(PG8_SA(1, 0), a3, voffA);
            PG8_WAIT_V(8); PG8_WAIT_L(0); PG8_BAR; PG8_MMA(1, 0, At, B0); PG8_MMA(1, 1, At, B1); PG8_BAR; PG8_SCHED;
        }
        if constexpr (ALIGN_EPI) { if (wr == 0) PG8_BAR; }
        E(acc, cur, wr, wc, fr, fq);
#ifdef PROBE_EPI2
        if constexpr (EXPERT && !Epi::PERM) { asm volatile("" ::: "memory"); E(acc, cur, wr, wc, fr, fq); }
#endif
        if (!has_next) break;
#pragma unroll
        for (int a = 0; a < 2; ++a)
#pragma unroll
            for (int b = 0; b < 2; ++b)
#pragma unroll
                for (int m = 0; m < 4; ++m)
#pragma unroll
                    for (int n = 0; n < 2; ++n) acc[a][b][m][n] = acc_t{};
        cur = nxt; cA = nA; cB = nB; ++ui;
        if constexpr (ALIGN_EPI) { if (wr == 1) PG8_BAR; }
    }
    PG8_WAIT_V(0);
    if constexpr (!ALIGN_EPI) { if (wr == 0) PG8_BAR; }
    PG8_BAR;
#undef PG8_BPTR
#undef PG8_SA
#undef PG8_SB
#undef PG8_STAGE
#undef PG8_LDA
#undef PG8_LDB
#undef PG8_MMA
#undef PG8_WAIT_V
#undef PG8_WAIT_L
#undef PG8_BAR
#undef PG8_SCHED
}
}

constexpr int NWAVES = 8;
constexpr int D = 1024, NB = 16, SEQ = 4096, CTXL = 256, GW = 64;
constexpr int TL = NB * SEQ, TC = NB * CTXL, TT = TL + TC;
constexpr int PROJ_SRC = 3104, PP = 3328;
constexpr int C_GQ = 0, C_GK = 256, C_GV = 512, C_GR = 1024, C_NQ = 1536, C_NK = 2048, C_NV = 2560, C_LR = 3072;
constexpr int DFF = 2816, DFE = 3584, NE = 8;
constexpr float EPS = 1e-6f;
constexpr int MOE_MAXT = 520, MOE_SLT = 192, MOE_NSL = 3;

constexpr size_t MiB = 1u << 20;
constexpr size_t WS_CTL = 0, CTL_ZERO_BYTES = 1 * MiB;
constexpr size_t WS_MOD = 1 * MiB;
constexpr size_t WS_ROPE = WS_MOD + 2 * 17 * 6144 * 4;
constexpr size_t WS_MOE = 2 * MiB;
constexpr size_t MOE_E = 0, MOE_W = 512 * 1024, MOE_RANK = 1024 * 1024, MOE_POS = 1536 * 1024, MOE_HIST = 2048 * 1024, MOE_ROWTOK = 2048 * 1024 + 16384, MOE_TEXP = MOE_ROWTOK + (size_t)MOE_MAXT * 256 * 4 + 4096, MOE_META = MOE_TEXP + 4096;
constexpr size_t WS_VCT = 6 * MiB;
constexpr size_t WS_SROW = WS_VCT;
constexpr size_t WS_SSORT = WS_VCT + 512 * 1024;
constexpr size_t WS_SB_IN = WS_VCT + 1536 * 1024;
constexpr size_t WS_SB_GU0 = WS_SB_IN + 32 * 1024;
constexpr size_t WS_SB_GU1 = WS_SB_IN + 64 * 1024;
constexpr size_t WS_SB_D0 = WS_SB_IN + 300 * 1024;
constexpr size_t WS_SB_D1 = WS_SB_IN + 320 * 1024;
constexpr float HID_RANGE = 8.0f;
constexpr size_t WS_CTXB = 10 * MiB;
constexpr size_t WS_WIN = 26 * MiB;
constexpr size_t WS_WOUT = WS_WIN + 2 * (size_t)PP * D * 2;
constexpr size_t WS_WGU0 = WS_WOUT + 2 * (size_t)D * D * 2;
constexpr size_t WS_WD0 = WS_WGU0 + (size_t)2 * DFF * D * 2;
constexpr size_t WS_WGU1 = WS_WD0 + (size_t)D * DFF * 2;
constexpr size_t WS_WD1 = WS_WGU1 + (size_t)NE * 2 * DFE * D * 2;
constexpr size_t WS_WEND = WS_WD1 + (size_t)NE * D * DFE * 2;
constexpr size_t WS_H = 228 * MiB;
constexpr size_t WS_BIG = 364 * MiB;
constexpr size_t WS_O = 806 * MiB;
constexpr size_t WS_ASORT = WS_BIG;
constexpr size_t WS_OUTP = WS_BIG + 130 * MiB;
constexpr size_t WS_HIDS = WS_BIG + 390 * MiB;
constexpr size_t WS_HRES_A = 296 * MiB;
constexpr size_t WS_HRES_B = WS_HIDS + (size_t)MOE_SLT * 256 * DFE;
constexpr size_t WS_NAPART = 942 * MiB;
constexpr size_t WS_END = 1024 * MiB;
static_assert(WS_WEND <= WS_H && WS_H + (size_t)TT * D * 2 <= WS_BIG && WS_BIG + (size_t)TT * PP * 2 <= WS_O && WS_O + (size_t)2 * TT * 512 * 2 <= WS_END, "ws map");
static_assert(WS_ASORT + (size_t)MOE_MAXT * 256 * D <= WS_OUTP && WS_OUTP + (size_t)MOE_MAXT * 256 * D * 2 <= WS_HIDS && WS_HIDS + (size_t)MOE_SLT * 256 * DFE <= WS_END && WS_ROPE + 8192 <= WS_MOE && MOE_META + 256 <= 4 * MiB, "ws map 2");
static_assert(WS_H + (size_t)TT * D <= WS_HRES_A && WS_HRES_A + (size_t)(TL / 2) * D * 2 <= WS_BIG && WS_HRES_B + (size_t)(TL / 2) * D * 2 <= WS_END && MOE_SLT * MOE_NSL >= MOE_MAXT, "ws map 3");
constexpr int CW_TMO = 0, CW_BAR = 4096;

constexpr int RING_OFF = 0, RING_BYTES = 131072;
constexpr int IDX_OFF = 159744, IDX_BYTES = 256 * 4;
constexpr int LDSCTL_OFF = IDX_OFF + 1024, MISC_OFF = LDSCTL_OFF + 64, PTAB_OFF = MISC_OFF + 128;
constexpr int LDS_BYTES = 163840;
static_assert(PTAB_OFF + 256 <= LDS_BYTES, "LDS map");

#define LAS __attribute__((address_space(3)))
typedef unsigned short bf16;
typedef float f32x4 __attribute__((ext_vector_type(4)));
typedef short bf16x8 __attribute__((ext_vector_type(8)));
typedef short s16x4 __attribute__((ext_vector_type(4)));
typedef unsigned u32x4 __attribute__((ext_vector_type(4)));
typedef unsigned u32x2 __attribute__((ext_vector_type(2)));
#define RLX_AGENT __ATOMIC_RELAXED, __HIP_MEMORY_SCOPE_AGENT
#define LDS_WAIT() asm volatile("s_waitcnt lgkmcnt(0)" ::: "memory")
#define VM_WAIT() asm volatile("s_waitcnt vmcnt(0)" ::: "memory")
typedef float f32x2 __attribute__((ext_vector_type(2)));
typedef __bf16 bf16x2_t __attribute__((ext_vector_type(2)));
__device__ __forceinline__ unsigned pk2(float lo, float hi) { const f32x2 v = {lo, hi}; return __builtin_bit_cast(unsigned, __builtin_convertvector(v, bf16x2_t)); }
__device__ __forceinline__ unsigned f2bf(float f) { return pk2(f, 0.f) & 0xffffu; }
__device__ __forceinline__ float bflo(unsigned w) { return __builtin_bit_cast(float, w << 16); }
__device__ __forceinline__ float bfhi(unsigned w) { return __builtin_bit_cast(float, w & 0xffff0000u); }
__device__ __forceinline__ f32x4 mfma16(bf16x8 a, bf16x8 b, f32x4 c) { return __builtin_amdgcn_mfma_f32_16x16x32_bf16(a, b, c, 0, 0, 0); }
__device__ __forceinline__ s16x4 tr_read(const LAS unsigned char* p) { return __builtin_amdgcn_ds_read_tr16_b64_v4i16((LAS s16x4*)p); }

#define XB_TMO      128
#define XB_XCNT(j)  (256  + 64 * (j))
#define XB_XSUB(j)  (1280 + 64 * (j))
#define XB_XGEN(j)  (2304 + 64 * (j))
#define XB_TOP      3328
#define XB_TOPGEN   3392
#define XCD_BAR_WORDS 3456
#define XB_SPIN_CAP (1u << 18)
__device__ __forceinline__ unsigned xb_ld(unsigned* p)              { return __hip_atomic_load(p, __ATOMIC_RELAXED, __HIP_MEMORY_SCOPE_AGENT); }
__device__ __forceinline__ unsigned xb_add(unsigned* p, unsigned v) { return __hip_atomic_fetch_add(p, v, __ATOMIC_RELAXED, __HIP_MEMORY_SCOPE_AGENT); }
__device__ __forceinline__ unsigned xb_xcc_id() { return (unsigned)__builtin_amdgcn_s_getreg((3 << 11) | 20) & 0xFu; }
#define XB_SPIN(cond, bar) do { unsigned _sp = 0; while (cond) { __builtin_amdgcn_s_sleep(1); \
    if ((++_sp & 255u) == 0u) { if (xb_ld(&(bar)[XB_TMO])) break; if (_sp > XB_SPIN_CAP) { atomicAdd(&(bar)[XB_TMO], 1u); break; } } } } while (0)
struct XcdBarrier { unsigned* bar; unsigned x; volatile LAS unsigned* st; };
__device__ __forceinline__ XcdBarrier xcd_barrier_post(unsigned* bar, volatile LAS unsigned* st) {
    XcdBarrier b; b.bar = bar; b.x = xb_xcc_id(); b.st = st;
    if (threadIdx.x == 0) (void)xb_add(&bar[XB_XCNT(b.x)], 1u);
    return b;
}
__device__ __forceinline__ void xcd_barrier_complete(unsigned* bar, unsigned x, unsigned& nloc, unsigned& nx) {
    const unsigned G = gridDim.x * gridDim.y * gridDim.z;
    unsigned sum, cnt, mine, sp = 0u;
    for (;;) {
        sum = 0u; cnt = 0u; mine = 0u;
#pragma unroll
        for (unsigned j = 0; j < 16; ++j) { const unsigned c = xb_ld(&bar[XB_XCNT(j)]); sum += c; cnt += (c > 0u) ? 1u : 0u; mine = (j == x) ? c : mine; }
        if (sum == G) break;
        __builtin_amdgcn_s_sleep(1);
        if ((++sp & 255u) == 0u) { if (xb_ld(&bar[XB_TMO])) break; if (sp > XB_SPIN_CAP) { atomicAdd(&bar[XB_TMO], 1u); break; } }
    }
    nloc = mine > 0u ? mine : 1u; nx = cnt > 0u ? cnt : 1u;
}
__device__ __forceinline__ void xcd_barrier(const XcdBarrier& b) {
    asm volatile("s_waitcnt vmcnt(0)" ::: "memory");
    __syncthreads();
    if (threadIdx.x == 0) {
        unsigned* bar = b.bar;
        __builtin_amdgcn_s_waitcnt(0);
        unsigned nloc = b.st[0], nx = b.st[1];
        if (nloc == 0u) { xcd_barrier_complete(bar, b.x, nloc, nx); b.st[0] = nloc; b.st[1] = nx; }
        const unsigned old = xb_add(&bar[XB_XSUB(b.x)], 1u);
        const unsigned gen = old / nloc;
        if (old + 1u == (gen + 1u) * nloc) {
            __builtin_amdgcn_fence(__ATOMIC_RELEASE, "agent");
            asm volatile("s_waitcnt vmcnt(0)" ::: "memory");
            const unsigned og = xb_add(&bar[XB_TOP], 1u);
            const unsigned tg = og / nx;
            if (og + 1u == (tg + 1u) * nx) xb_add(&bar[XB_TOPGEN], 1u);
            else XB_SPIN(xb_ld(&bar[XB_TOPGEN]) == tg, bar);
            __builtin_amdgcn_fence(__ATOMIC_ACQUIRE, "agent");
            xb_add(&bar[XB_XGEN(b.x)], 1u);
            asm volatile("s_waitcnt vmcnt(0)" ::: "memory");
        } else {
            XB_SPIN(xb_ld(&bar[XB_XGEN(b.x)]) == gen, bar);
            __builtin_amdgcn_fence(__ATOMIC_ACQUIRE, "agent");
            asm volatile("s_waitcnt vmcnt(0)" ::: "memory");
        }
    }
    __syncthreads();
}

struct Frame {
    LAS unsigned char* lds;
    int tid, lane, wave, vcu, G;
    unsigned char* ws;
    float* out;
    __device__ __forceinline__ const float* inp(int i) const { const LAS unsigned* pt = (const LAS unsigned*)(lds + PTAB_OFF) + 2 * i; const unsigned lo = __builtin_amdgcn_readfirstlane(pt[0]), hi = __builtin_amdgcn_readfirstlane(pt[1]); return (const float*)(((unsigned long long)hi << 32) | lo); }
};
enum { I_X = 0, I_C, I_CTX, I_CCTX, I_WADA, I_BADA, I_GPREMIX, I_GPOSTMIX, I_GPREFFN, I_GPOSTFFN, I_WIN, I_GWG, I_GBG, I_GGN, I_RPB, I_WOUT, I_FWG, I_FWU, I_FWD, I_MWR, I_MWG, I_MWU, I_MWD };

template <int CTRL> __device__ __forceinline__ float dpp_f(float v) { return __builtin_bit_cast(float, __builtin_amdgcn_update_dpp(0, __builtin_bit_cast(int, v), CTRL, 0xf, 0xf, true)); }
struct OpAdd { static __device__ __forceinline__ float f(float a, float b) { return a + b; } };
struct OpMax { static __device__ __forceinline__ float f(float a, float b) { return fmaxf(a, b); } };
template <class Op> __device__ __forceinline__ float red_x16(float v) { const unsigned u = __builtin_bit_cast(unsigned, v); const auto r = __builtin_amdgcn_permlane16_swap(u, u, false, false);
    return Op::f(__builtin_bit_cast(float, (unsigned)r[0]), __builtin_bit_cast(float, (unsigned)r[1])); }
template <class Op> __device__ __forceinline__ float red_x32(float v) { const unsigned u = __builtin_bit_cast(unsigned, v); const auto r = __builtin_amdgcn_permlane32_swap(u, u, false, false);
    return Op::f(__builtin_bit_cast(float, (unsigned)r[0]), __builtin_bit_cast(float, (unsigned)r[1])); }
template <class Op> __device__ __forceinline__ float red_row16(float v) {
    v = Op::f(v, dpp_f<0xB1>(v)); v = Op::f(v, dpp_f<0x4E>(v)); v = Op::f(v, dpp_f<0x141>(v)); return Op::f(v, dpp_f<0x140>(v)); }
template <class Op> __device__ __forceinline__ float red_wave(float v) { return red_x32<Op>(red_x16<Op>(red_row16<Op>(v))); }
__device__ __forceinline__ float wave_sum(float v) { return red_wave<OpAdd>(v); }

__device__ __forceinline__ int dst_row(int n, int mode) {
    if (mode == 0) return n;
    if (mode == 1) return n < 1536 ? n : (n < 1568 ? n + 1536 : n - 32);
    return 32 * (n >> 4) + (n & 15) + (mode == 3 ? 16 : 0);
}
__device__ __forceinline__ void p0_transpose_item(const float* W, int K, int N, bf16* WT, int mode, LAS float* scr, int item, int lane) {
    const int nblk = N / 32, kb = item / nblk, nb = item % nblk, k0 = 64 * kb, n0 = 32 * nb;
    const int kr = lane >> 3, n4 = lane & 7;
    f32x4 v[8];
#pragma unroll
    for (int i = 0; i < 8; ++i) v[i] = *(const f32x4*)(W + (size_t)(k0 + 8 * i + kr) * N + n0 + 4 * n4);
#pragma unroll
    for (int i = 0; i < 8; ++i) { LAS float* d = scr + (8 * i + kr) * 33 + 4 * n4; d[0] = v[i][0]; d[1] = v[i][1]; d[2] = v[i][2]; d[3] = v[i][3]; }
    LDS_WAIT(); asm volatile("" ::: "memory");
    const int c = lane & 7;
#pragma unroll
    for (int j = 0; j < 4; ++j) { const int n = (lane >> 3) + 8 * j; const LAS float* s = scr + (8 * c) * 33 + n;
        u32x4 o; o.x = pg8::cvt_pk_bf16(s[0 * 33], s[1 * 33]); o.y = pg8::cvt_pk_bf16(s[2 * 33], s[3 * 33]); o.z = pg8::cvt_pk_bf16(s[4 * 33], s[5 * 33]); o.w = pg8::cvt_pk_bf16(s[6 * 33], s[7 * 33]);
        *(u32x4*)(WT + (size_t)dst_row(n0 + n, mode) * K + k0 + 8 * c) = o; }
    LDS_WAIT(); asm volatile("" ::: "memory");
}

constexpr int P0_NH = 2;
struct P0Item { const float* W; int K, N; signed char* W8; float* sb; int mode, nb; };
struct P0Hold { f32x4 v[P0_NH][8]; };
__device__ __forceinline__ void p0q_load(const P0Item& it, P0Hold& H, int wave, int lane) {
    const int n0 = 32 * it.nb, kr = lane >> 3, n4 = lane & 7, nsub = it.K / 64;
#pragma unroll
    for (int h = 0; h < P0_NH; ++h) { const int j = min(wave + 8 * h, nsub - 1); const int k0 = 64 * j;
#pragma unroll
        for (int i = 0; i < 8; ++i) H.v[h][i] = *(const f32x4*)(it.W + (size_t)(k0 + 8 * i + kr) * it.N + n0 + 4 * n4); }
}
__device__ __forceinline__ void p0q_finish(const P0Item& it, const P0Hold& H, LAS float* scr, LAS float* AM, int wave, int lane) {
    const float* W = it.W; const int K = it.K, N = it.N, mode = it.mode; signed char* W8 = it.W8;
    const int n0 = 32 * it.nb, kr = lane >> 3, n4 = lane & 7, nsub = K / 64;
    f32x4 am = (f32x4){0.f, 0.f, 0.f, 0.f};
#pragma unroll
    for (int h = 0; h < P0_NH; ++h)
#pragma unroll
        for (int i = 0; i < 8; ++i) { const f32x4 v = H.v[h][i];
            am[0] = fmaxf(am[0], fabsf(v[0])); am[1] = fmaxf(am[1], fabsf(v[1])); am[2] = fmaxf(am[2], fabsf(v[2])); am[3] = fmaxf(am[3], fabsf(v[3])); }
    for (int j = wave + 8 * P0_NH; j < nsub; j += 8) { const int k0 = 64 * j;
#pragma unroll
        for (int i = 0; i < 8; ++i) { const f32x4 v = *(const f32x4*)(W + (size_t)(k0 + 8 * i + kr) * N + n0 + 4 * n4);
            am[0] = fmaxf(am[0], fabsf(v[0])); am[1] = fmaxf(am[1], fabsf(v[1])); am[2] = fmaxf(am[2], fabsf(v[2])); am[3] = fmaxf(am[3], fabsf(v[3])); } }
#pragma unroll
    for (int q = 0; q < 4; ++q) { float a = am[q]; a = fmaxf(a, dpp_f<0x128>(a)); a = red_x32<OpMax>(red_x16<OpMax>(a)); am[q] = a; }
    if (kr == 0) *(LAS f32x4*)(AM + wave * 32 + 4 * n4) = am;
    __syncthreads();
#pragma unroll
    for (int w2 = 0; w2 < 8; ++w2) { const f32x4 o = *(const LAS f32x4*)(AM + w2 * 32 + 4 * n4); am[0] = fmaxf(am[0], o[0]); am[1] = fmaxf(am[1], o[1]); am[2] = fmaxf(am[2], o[2]); am[3] = fmaxf(am[3], o[3]); }
    f32x4 inv;
#pragma unroll
    for (int q = 0; q < 4; ++q) inv[q] = am[q] > 0.f ? 127.0f / am[q] : 0.f;
    if (wave == 0 && kr == 0) {
#pragma unroll
        for (int q = 0; q < 4; ++q) it.sb[dst_row(n0 + 4 * n4 + q, mode)] = am[q] * (1.0f / 127.0f); }
    const int c = lane & 7;
    auto emit = [&](const f32x4 (&v)[8], int k0) {
#pragma unroll
        for (int i = 0; i < 8; ++i) { LAS float* d = scr + (8 * i + kr) * 33 + 4 * n4; d[0] = v[i][0]; d[1] = v[i][1]; d[2] = v[i][2]; d[3] = v[i][3]; }
        LDS_WAIT(); asm volatile("" ::: "memory");
#pragma unroll
        for (int jj = 0; jj < 4; ++jj) { const int n = (lane >> 3) + 8 * jj; const LAS float* s = scr + (8 * c) * 33 + n;
            unsigned lo = 0u, hi = 0u;
#pragma unroll
            for (int e = 0; e < 4; ++e) { lo |= ((unsigned)(int)__builtin_rintf(s[e * 33]) & 255u) << (8 * e); hi |= ((unsigned)(int)__builtin_rintf(s[(4 + e) * 33]) & 255u) << (8 * e); }
            *(u32x2*)(W8 + (size_t)dst_row(n0 + n, mode) * K + k0 + 8 * c) = (u32x2){lo, hi}; }
        LDS_WAIT(); asm volatile("" ::: "memory"); };
#pragma unroll
    for (int h = 0; h < P0_NH; ++h) { f32x4 v[8];
#pragma unroll
        for (int i = 0; i < 8; ++i) v[i] = H.v[h][i] * inv;
        emit(v, 64 * (wave + 8 * h)); }
    for (int j = wave + 8 * P0_NH; j < nsub; j += 8) { const int k0 = 64 * j;
        f32x4 v[8];
#pragma unroll
        for (int i = 0; i < 8; ++i) v[i] = *(const f32x4*)(W + (size_t)(k0 + 8 * i + kr) * N + n0 + 4 * n4) * inv;
        emit(v, k0); }
    __syncthreads();
}
__device__ __forceinline__ void p0_prologue(Frame& F) {
    if (F.vcu < 192) {
        LAS float* SL = (LAS float*)(F.lds);
        LAS float* PS = (LAS float*)(F.lds + 17 * 1024 * 4);
        for (int i = F.tid; i < 17 * 1024; i += 512) { const float v = i < 16 * 1024 ? F.inp(I_C)[i] : F.inp(I_CCTX)[i - 16 * 1024]; SL[i] = v / (1.0f + __expf(-v)); }
        __syncthreads();
        const int l = F.vcu / 96, cb = F.vcu % 96, col = 64 * cb + F.lane;
        const float* W = F.inp(I_WADA) + (size_t)l * D * 6144 + col;
        float acc[17];
#pragma unroll
        for (int r = 0; r < 17; ++r) acc[r] = 0.f;
#pragma unroll 4
        for (int k4 = 0; k4 < 32; ++k4) { const int k = 128 * F.wave + 4 * k4;
            const float w0 = W[(size_t)(k + 0) * 6144], w1 = W[(size_t)(k + 1) * 6144], w2 = W[(size_t)(k + 2) * 6144], w3 = W[(size_t)(k + 3) * 6144];
#pragma unroll
            for (int r = 0; r < 17; ++r) { const f32x4 s = *(const LAS f32x4*)(SL + r * 1024 + k); acc[r] += s[0] * w0 + s[1] * w1 + s[2] * w2 + s[3] * w3; } }
#pragma unroll
        for (int r = 0; r < 17; ++r) PS[(F.wave * 17 + r) * 64 + F.lane] = acc[r];
        __syncthreads();
        float* mod = (float*)(F.ws + WS_MOD);
        for (int i = F.tid; i < 17 * 64; i += 512) { const int r = i >> 6, c = i & 63; float s = 0.f;
#pragma unroll
            for (int w = 0; w < 8; ++w) s += PS[(w * 17 + r) * 64 + c];
            mod[((size_t)l * 17 + r) * 6144 + 64 * cb + c] = s + F.inp(I_BADA)[l * 6144 + 64 * cb + c]; }
        __syncthreads();
    }
    if (F.vcu == 255) { float* rt = (float*)(F.ws + WS_ROPE);
        for (int i = F.tid; i < 1024; i += 512) { const int pos = i >> 4, fi = i & 15; const float inv = exp2f(-(float)fi * (13.287712379549449f / 16.0f)); const float a = (float)pos * inv; rt[2 * i] = cosf(a); rt[2 * i + 1] = sinf(a); } }
    { signed char* win = (signed char*)(F.ws + WS_WIN); const int gt = F.vcu * 512 + F.tid, NT = F.G * 512;
      for (int i = gt; i < 2 * 224 * 64; i += NT) { const int l = i / (224 * 64), r = i % (224 * 64); *(u32x4*)(win + ((size_t)l * PP + PROJ_SRC) * D + (size_t)r * 16) = (u32x4){0u, 0u, 0u, 0u}; }
      if (gt < 2 * 224) ((float*)(F.ws + WS_SB_IN))[(gt / 224) * PP + PROJ_SRC + gt % 224] = 0.f; }
    LAS float* scr = (LAS float*)(F.lds + RING_OFF + F.wave * 16384);
    LAS float* AM = (LAS float*)(F.lds + 140000 + 0);
    constexpr int QA = 97, QC = 88, QE = 112, QF = 32;
    constexpr int NWI = 8 * QF + QF + 16 * QE + 2 * QC + 2 * QA;
    auto item = [&](int r) { P0Item q;
        if (r < 8 * QF) { const int e = r / QF; q = P0Item{F.inp(I_MWD) + (size_t)e * DFE * D, DFE, D, (signed char*)(F.ws + WS_WD1) + (size_t)e * D * DFE, (float*)(F.ws + WS_SB_D1) + (size_t)e * D, 0, r % QF}; return q; } r -= 8 * QF;
        if (r < QF) { q = P0Item{F.inp(I_FWD), DFF, D, (signed char*)(F.ws + WS_WD0), (float*)(F.ws + WS_SB_D0), 0, r}; return q; } r -= QF;
        if (r < 16 * QE) { const int m = r / QE, e = m >> 1, w = m & 1; q = P0Item{F.inp(w ? I_MWU : I_MWG) + (size_t)e * D * DFE, D, DFE, (signed char*)(F.ws + WS_WGU1) + (size_t)e * 2 * DFE * D, (float*)(F.ws + WS_SB_GU1) + (size_t)e * 2 * DFE, 2 + w, r % QE}; return q; } r -= 16 * QE;
        if (r < 2 * QC) { const int w = r / QC; q = P0Item{F.inp(w ? I_FWU : I_FWG), D, DFF, (signed char*)(F.ws + WS_WGU0), (float*)(F.ws + WS_SB_GU0), 2 + w, r % QC}; return q; } r -= 2 * QC;
        { const int l = r / QA; q = P0Item{F.inp(I_WIN) + (size_t)l * D * PROJ_SRC, D, PROJ_SRC, (signed char*)(F.ws + WS_WIN) + (size_t)l * PP * D, (float*)(F.ws + WS_SB_IN) + (size_t)l * PP, 1, r % QA}; return q; } };
    { LAS int* QS = (LAS int*)(F.lds + 140000 + 1024); int* qctr = (int*)(F.ws + WS_CTL + 600 * 1024);
      auto grab = [&]() { return __hip_atomic_fetch_add(qctr, 1, __ATOMIC_RELAXED, __HIP_MEMORY_SCOPE_AGENT); };
      if (F.tid == 0) { QS[0] = grab(); QS[1] = grab(); }
      __syncthreads();
      int it = QS[0], i1 = QS[1]; P0Item ia, ib; P0Hold ha, hb;
      if (it < NWI) { ia = item(it); p0q_load(ia, ha, F.wave, F.lane); }
      __syncthreads();
#pragma unroll 1
      while (it < NWI) {
          const bool v1 = i1 < NWI;
          if (v1) { ib = item(i1); p0q_load(ib, hb, F.wave, F.lane); }
          if (F.tid == 0) QS[0] = v1 ? grab() : NWI;
          p0q_finish(ia, ha, scr, AM, F.wave, F.lane);
          if (!v1) break;
          const int i2 = QS[0]; const bool v2 = i2 < NWI;
          if (v2) { ia = item(i2); p0q_load(ia, ha, F.wave, F.lane); }
          if (F.tid == 0) QS[1] = v2 ? grab() : NWI;
          p0q_finish(ib, hb, scr, AM, F.wave, F.lane);
          it = i2; i1 = QS[1]; } }
    const int gw = F.vcu * NWAVES + F.wave, NGW = F.G * NWAVES;
    constexpr int IB = 16 * 32;
    for (int it = gw; it < 2 * IB; it += NGW) { const int l = it / IB; p0_transpose_item(F.inp(I_WOUT) + (size_t)l * D * D, D, D, (bf16*)(F.ws + WS_WOUT) + (size_t)l * D * D, 0, scr, it % IB, F.lane); }
}

struct Row { f32x4 v[4]; };
__device__ __forceinline__ Row ld_f32(const float* p, int lane) { Row r;
#pragma unroll
    for (int j = 0; j < 4; ++j) r.v[j] = __builtin_nontemporal_load((const f32x4*)(p + 4 * lane + 256 * j));
    return r; }
__device__ __forceinline__ void st_f32(float* p, int lane, const Row& r) {
#pragma unroll
    for (int j = 0; j < 4; ++j) __builtin_nontemporal_store(r.v[j], (f32x4*)(p + 4 * lane + 256 * j)); }
__device__ __forceinline__ Row ld_bf16(const bf16* p, int lane) { Row r;
#pragma unroll
    for (int j = 0; j < 4; ++j) { const u32x2 w = *(const u32x2*)(p + 4 * lane + 256 * j); r.v[j] = (f32x4){bflo(w.x), bfhi(w.x), bflo(w.y), bfhi(w.y)}; }
    return r; }
__device__ __forceinline__ void st_bf16(bf16* p, int lane, const Row& r) {
#pragma unroll
    for (int j = 0; j < 4; ++j) { u32x2 w; w.x = pk2(r.v[j][0], r.v[j][1]); w.y = pk2(r.v[j][2], r.v[j][3]); *(u32x2*)(p + 4 * lane + 256 * j) = w; } }
__device__ __forceinline__ Row ld_bf16nt(const bf16* p, int lane) { Row r;
#pragma unroll
    for (int j = 0; j < 4; ++j) { const u32x2 w = __builtin_nontemporal_load((const u32x2*)(p + 4 * lane + 256 * j)); r.v[j] = (f32x4){bflo(w.x), bfhi(w.x), bflo(w.y), bfhi(w.y)}; }
    return r; }
__device__ __forceinline__ void st_bf16nt(bf16* p, int lane, const Row& r) {
#pragma unroll
    for (int j = 0; j < 4; ++j) { u32x2 w; w.x = pk2(r.v[j][0], r.v[j][1]); w.y = pk2(r.v[j][2], r.v[j][3]); __builtin_nontemporal_store(w, (u32x2*)(p + 4 * lane + 256 * j)); } }
__device__ __forceinline__ bf16* hres1(Frame& F, int row) { return (bf16*)(F.ws + (row < TL / 2 ? WS_HRES_A : WS_HRES_B - (size_t)(TL / 2) * D * 2)) + (size_t)row * D; }
__device__ __forceinline__ float row_rinv(const Row& r) { float s = 0.f;
#pragma unroll
    for (int j = 0; j < 4; ++j) s += (r.v[j][0] * r.v[j][0] + r.v[j][1] * r.v[j][1]) + (r.v[j][2] * r.v[j][2] + r.v[j][3] * r.v[j][3]);
    return 1.0f / sqrtf(wave_sum(s) * (1.0f / D) + EPS); }
__device__ __forceinline__ float wave_max(float v) { return red_wave<OpMax>(v); }
__device__ __forceinline__ void st_q8(signed char* p, float* srow, int lane, const Row& r) {
    float am = 0.f;
#pragma unroll
    for (int j = 0; j < 4; ++j) am = fmaxf(am, fmaxf(fmaxf(fabsf(r.v[j][0]), fabsf(r.v[j][1])), fmaxf(fabsf(r.v[j][2]), fabsf(r.v[j][3]))));
    am = wave_max(am);
    const float inv = am > 0.f ? 127.0f / am : 0.f;
#pragma unroll
    for (int j = 0; j < 4; ++j) { unsigned w = 0u;
#pragma unroll
        for (int e = 0; e < 4; ++e) w |= ((unsigned)(int)__builtin_rintf(r.v[j][e] * inv) & 255u) << (8 * e);
        *(unsigned*)(p + 4 * lane + 256 * j) = w; }
    if (lane == 0) *srow = am * (1.0f / 127.0f);
}
__device__ __forceinline__ const float* modp(Frame& F, int l, int r, int which) { return (const float*)(F.ws + WS_MOD) + (((size_t)l * 17 + r) * 6 + which) * 1024; }

__device__ __forceinline__ void t1_prenorm(Frame& F) {
    const int gw = F.vcu * NWAVES + F.wave; signed char* H8 = (signed char*)(F.ws + WS_H); float* SR = (float*)(F.ws + WS_SROW);
    const Row g = ld_f32(F.inp(I_GPREMIX), F.lane);
    for (int seg = 0; seg < 2; ++seg) {
        const int r0 = seg ? TL + 2 * gw : 32 * gw, nr = seg ? 2 : 32, mr = seg ? 16 : (gw >> 7);
        const Row sc = ld_f32(modp(F, 0, mr, 1), F.lane), sh = ld_f32(modp(F, 0, mr, 0), F.lane);
        const float* src0 = seg ? F.inp(I_CTX) + (size_t)(r0 - TL) * D : F.inp(I_X) + (size_t)r0 * D;
        Row xn = ld_f32(src0, F.lane);
        for (int i = 0; i < nr; ++i) { const int row = r0 + i;
            Row x = xn; if (i + 1 < nr) xn = ld_f32(src0 + (size_t)(i + 1) * D, F.lane);
            const float ri = row_rinv(x);
#pragma unroll
            for (int j = 0; j < 4; ++j) x.v[j] = (x.v[j] * ri * g.v[j]) * (1.0f + sc.v[j]) + sh.v[j];
            st_q8(H8 + (size_t)row * D, SR + row, F.lane, x); }
    }
}
__device__ __forceinline__ void t2_postmix(Frame& F, int l) {
    const int gw = F.vcu * NWAVES + F.wave; signed char* H8 = (signed char*)(F.ws + WS_H); float* SR = (float*)(F.ws + WS_SROW); const bf16* Y = (const bf16*)(F.ws + WS_BIG);
    float* ctxb = (float*)(F.ws + WS_CTXB);
    const Row gpm = ld_f32(F.inp(I_GPOSTMIX) + l * D, F.lane), gpf = ld_f32(F.inp(I_GPREFFN) + l * D, F.lane);
    LAS float* WR = (LAS float*)(F.lds);
    LAS int* CNT = (LAS int*)(F.lds + 32768);
    if (l == 1) { for (int i = F.tid; i < 8192; i += 512) WR[i] = F.inp(I_MWR)[i]; if (F.tid < 8) CNT[F.tid] = 0; __syncthreads(); }
    const int nseg = l == 0 ? 2 : 1;
    for (int seg = 0; seg < nseg; ++seg) {
        const int r0 = seg ? TL + 2 * gw : 32 * gw, nr = seg ? 2 : 32, mr = seg ? 16 : (gw >> 7);
        const Row gt1 = ld_f32(modp(F, l, mr, 2), F.lane), sc2 = ld_f32(modp(F, l, mr, 4), F.lane), sh2 = ld_f32(modp(F, l, mr, 3), F.lane);
        const float* xs0 = seg ? F.inp(I_CTX) + (size_t)(r0 - TL) * D : F.inp(I_X) + (size_t)r0 * D;
        const bf16* xb0 = (const bf16*)F.out + (size_t)r0 * D;
        bf16* xdb = l == 0 ? (bf16*)F.out : hres1(F, r0) - (size_t)r0 * D;
        Row yn = ld_bf16(Y + (size_t)r0 * D, F.lane), xn = l == 0 ? ld_f32(xs0, F.lane) : ld_bf16nt(xb0, F.lane);
        for (int i = 0; i < nr; ++i) { const int row = r0 + i;
            const Row y = yn; Row x = xn;
            if (i + 1 < nr) { yn = ld_bf16(Y + (size_t)(row + 1) * D, F.lane); xn = l == 0 ? ld_f32(xs0 + (size_t)(i + 1) * D, F.lane) : ld_bf16nt(xb0 + (size_t)(i + 1) * D, F.lane); }
            const float ry = row_rinv(y);
#pragma unroll
            for (int j = 0; j < 4; ++j) x.v[j] = x.v[j] + gt1.v[j] * (y.v[j] * ry * gpm.v[j]);
            if (seg) st_f32(ctxb + (size_t)(row - TL) * D, F.lane, x); else st_bf16nt(xdb + (size_t)row * D, F.lane, x);
            const float r2 = row_rinv(x);
#pragma unroll
            for (int j = 0; j < 4; ++j) x.v[j] = (x.v[j] * r2 * gpf.v[j]) * (1.0f + sc2.v[j]) + sh2.v[j];
            st_q8(H8 + (size_t)row * D, SR + row, F.lane, x);
            if (l == 1) {
                float lg[8];
#pragma unroll
                for (int e = 0; e < 8; ++e) lg[e] = 0.f;
#pragma unroll
                for (int j = 0; j < 4; ++j)
#pragma unroll
                    for (int q = 0; q < 4; ++q) { const LAS float* w = WR + (4 * F.lane + 256 * j + q) * 8; const f32x4 w0 = *(const LAS f32x4*)w, w1 = *(const LAS f32x4*)(w + 4); const float hv = x.v[j][q];
                        lg[0] += hv * w0[0]; lg[1] += hv * w0[1]; lg[2] += hv * w0[2]; lg[3] += hv * w0[3]; lg[4] += hv * w1[0]; lg[5] += hv * w1[1]; lg[6] += hv * w1[2]; lg[7] += hv * w1[3]; }
#pragma unroll
                for (int e = 0; e < 8; ++e) lg[e] = wave_sum(lg[e]);
                int i1 = 0; float v1 = lg[0];
#pragma unroll
                for (int e = 1; e < 8; ++e) if (lg[e] > v1) { v1 = lg[e]; i1 = e; }
                int i2 = -1; float v2 = -3.0e38f;
#pragma unroll
                for (int e = 0; e < 8; ++e) if (e != i1 && lg[e] > v2) { v2 = lg[e]; i2 = e; }
                if (i2 < 0) i2 = i1 == 0 ? 1 : 0;
                const float w2 = 1.0f / (1.0f + __expf(v1 - v2)), w1 = 1.0f - w2;
                if (F.lane == 0) { int* te = (int*)(F.ws + WS_MOE + MOE_E); float* tw = (float*)(F.ws + WS_MOE + MOE_W); int* tr = (int*)(F.ws + WS_MOE + MOE_RANK);
                    te[2 * row] = i1; te[2 * row + 1] = i2; tw[2 * row] = w1; tw[2 * row + 1] = w2;
                    tr[2 * row] = atomicAdd((int*)(CNT + i1), 1); tr[2 * row + 1] = atomicAdd((int*)(CNT + i2), 1); }
            }
        }
    }
    if (l == 1) { __syncthreads(); if (F.tid < 8) ((int*)(F.ws + WS_MOE + MOE_HIST))[F.vcu * 8 + F.tid] = CNT[F.tid]; }
}
__device__ __forceinline__ void m2_lists(Frame& F) {
    LAS int* L = (LAS int*)(F.lds);
    const int* hist = (const int*)(F.ws + WS_MOE + MOE_HIST);
    if (F.wave == 0) {
        int tot[8], pre[8];
#pragma unroll
        for (int e = 0; e < 8; ++e) { int t = 0, p = 0;
#pragma unroll
            for (int q = 0; q < 4; ++q) { const int wg = F.lane + 64 * q; const int hv = hist[wg * 8 + e]; t += hv; p += (wg < F.vcu) ? hv : 0; }
#pragma unroll
            for (int o = 1; o < 64; o <<= 1) { t += __shfl_xor(t, o); p += __shfl_xor(p, o); }
            tot[e] = t; pre[e] = p; }
        if (F.lane == 0) { int base = 0;
#pragma unroll
            for (int e = 0; e < 8; ++e) { L[e] = base * 256; L[8 + e] = pre[e]; L[16 + e] = tot[e]; base += (tot[e] + 255) >> 8; }
            L[24] = base; }
    }
    __syncthreads();
    const int* te = (const int*)(F.ws + WS_MOE + MOE_E); const int* tr = (const int*)(F.ws + WS_MOE + MOE_RANK);
    int* tp = (int*)(F.ws + WS_MOE + MOE_POS); int* rtok = (int*)(F.ws + WS_MOE + MOE_ROWTOK);
    { const int pair = F.vcu * 512 + F.tid;
      const int e = min(max(te[pair], 0), 7); const int pos = min(max(L[e] + L[8 + e] + tr[pair], 0), MOE_MAXT * 256 - 1); tp[pair] = pos; rtok[pos] = pair >> 1; }
    if (F.vcu < 8) { const int e = F.vcu; const int cnt = L[16 + e], end = ((cnt + 255) >> 8) << 8; for (int i = cnt + F.tid; i < end; i += 512) rtok[L[e] + i] = 0; }
    if (F.vcu == 8) { int* tex = (int*)(F.ws + WS_MOE + MOE_TEXP);
        for (int t = F.tid; t < MOE_MAXT + 8; t += 512) { int e = 7;
#pragma unroll
            for (int q = 7; q >= 1; --q) if (t * 256 < L[q]) e = q - 1;
            tex[t] = e; }
        if (F.tid == 0) ((int*)(F.ws + WS_MOE + MOE_META))[0] = L[24]; }
}
__device__ __forceinline__ void m2_lists_gather(Frame& F) {
    LAS int* L = (LAS int*)(F.lds);
    LAS int* P = (LAS int*)(F.lds + 1024);
    const int* hist = (const int*)(F.ws + WS_MOE + MOE_HIST);
    if (F.wave == 0) {
        int tot[8], pre[8];
#pragma unroll
        for (int e = 0; e < 8; ++e) { int t = 0, p = 0;
#pragma unroll
            for (int q = 0; q < 4; ++q) { const int wg = F.lane + 64 * q; const int hv = hist[wg * 8 + e]; t += hv; p += (wg < F.vcu) ? hv : 0; }
#pragma unroll
            for (int o = 1; o < 64; o <<= 1) { t += __shfl_xor(t, o); p += __shfl_xor(p, o); }
            tot[e] = t; pre[e] = p; }
        if (F.lane == 0) { int base = 0;
#pragma unroll
            for (int e = 0; e < 8; ++e) { L[e] = base * 256; L[8 + e] = pre[e]; L[16 + e] = tot[e]; base += (tot[e] + 255) >> 8; }
            L[24] = base; }
    }
    __syncthreads();
    const int* te = (const int*)(F.ws + WS_MOE + MOE_E); const int* tr = (const int*)(F.ws + WS_MOE + MOE_RANK);
    int* tp = (int*)(F.ws + WS_MOE + MOE_POS); float* SS = (float*)(F.ws + WS_SSORT);
    { const int pair = F.vcu * 512 + F.tid;
      const int e = min(max(te[pair], 0), 7); const int pos = min(max(L[e] + L[8 + e] + tr[pair], 0), MOE_MAXT * 256 - 1); tp[pair] = pos; P[F.tid] = pos; }
    if (F.vcu < 8) { const int e = F.vcu; const int cnt = L[16 + e], end = ((cnt + 255) >> 8) << 8; for (int i = cnt + F.tid; i < end; i += 512) SS[min(L[e] + i, MOE_MAXT * 256 - 1)] = 0.f; }
    if (F.vcu == 8) { int* tex = (int*)(F.ws + WS_MOE + MOE_TEXP);
        for (int t = F.tid; t < MOE_MAXT + 8; t += 512) { int e = 7;
#pragma unroll
            for (int q = 7; q >= 1; --q) if (t * 256 < L[q]) e = q - 1;
            tex[t] = e; }
        if (F.tid == 0) ((int*)(F.ws + WS_MOE + MOE_META))[0] = L[24]; }
    __syncthreads();
    const signed char* H8 = (const signed char*)(F.ws + WS_H); signed char* AS = (signed char*)(F.ws + WS_ASORT); const float* SR = (const float*)(F.ws + WS_SROW);
    const int tok0 = F.vcu * 256 + 32 * F.wave;
    for (int j = 0; j < 32; j += 4) {
        u32x4 a[4]; float sc[4];
#pragma unroll
        for (int q = 0; q < 4; ++q) { a[q] = *(const u32x4*)(H8 + (size_t)(tok0 + j + q) * D + 16 * F.lane); sc[q] = SR[tok0 + j + q]; }
#pragma unroll
        for (int q = 0; q < 4; ++q) { const int pa = P[64 * F.wave + 2 * (j + q)], pb = P[64 * F.wave + 2 * (j + q) + 1];
            *(u32x4*)(AS + (size_t)pa * D + 16 * F.lane) = a[q]; *(u32x4*)(AS + (size_t)pb * D + 16 * F.lane) = a[q];
            if (F.lane == 0) { SS[pa] = sc[q]; SS[pb] = sc[q]; } } }
}
__device__ __forceinline__ void t3_postffn(Frame& F, int l) {
    const int gw = F.vcu * NWAVES + F.wave; signed char* H8 = (signed char*)(F.ws + WS_H); float* SR = (float*)(F.ws + WS_SROW); float* ctxb = (float*)(F.ws + WS_CTXB);
    const Row gpo = ld_f32(F.inp(I_GPOSTFFN) + l * D, F.lane);
    const int nseg = l == 0 ? 2 : 1;
    for (int seg = 0; seg < nseg; ++seg) {
        const int r0 = seg ? TL + 2 * gw : 32 * gw, nr = seg ? 2 : 32, mr = seg ? 16 : (gw >> 7);
        const Row gt2 = ld_f32(modp(F, l, mr, 5), F.lane);
        Row gn, scn, shn;
        if (l == 0) { gn = ld_f32(F.inp(I_GPREMIX) + D, F.lane); scn = ld_f32(modp(F, 1, mr, 1), F.lane); shn = ld_f32(modp(F, 1, mr, 0), F.lane); }
        const int* tp = (const int*)(F.ws + WS_MOE + MOE_POS); const float* tw = (const float*)(F.ws + WS_MOE + MOE_W); const bf16* OP = (const bf16*)(F.ws + WS_OUTP); const bf16* FB = (const bf16*)(F.ws + WS_O);
        float* xp0 = seg ? ctxb + (size_t)(r0 - TL) * D : F.out + (size_t)r0 * D;
        const bf16* xb0 = l == 0 ? (const bf16*)F.out + (size_t)r0 * D : hres1(F, r0);
        const bool xf = seg != 0;
        int pan = 0, pbn = 0; float wan = 0.f, wbn = 0.f, wa = 0.f, wb = 0.f;
        Row fan, fbn, xn;
        if (l == 0) fan = ld_bf16(FB + (size_t)r0 * D, F.lane);
        else { const int pa0 = min(max(tp[2 * r0], 0), MOE_MAXT * 256 - 1), pb0 = min(max(tp[2 * r0 + 1], 0), MOE_MAXT * 256 - 1); wa = tw[2 * r0]; wb = tw[2 * r0 + 1]; fan = ld_bf16(OP + (size_t)pa0 * D, F.lane); fbn = ld_bf16(OP + (size_t)pb0 * D, F.lane);
            if (nr > 1) { pan = min(max(tp[2 * r0 + 2], 0), MOE_MAXT * 256 - 1); pbn = min(max(tp[2 * r0 + 3], 0), MOE_MAXT * 256 - 1); wan = tw[2 * r0 + 2]; wbn = tw[2 * r0 + 3]; } }
        xn = xf ? ld_f32(xp0, F.lane) : ld_bf16nt(xb0, F.lane);
        for (int i = 0; i < nr; ++i) { const int row = r0 + i;
            Row f = fan; Row x = xn; const float wac = wa, wbc = wb;
            if (l == 1) {
#pragma unroll
                for (int j = 0; j < 4; ++j) f.v[j] = fan.v[j] * wac + fbn.v[j] * wbc; }
            if (i + 1 < nr) {
                if (l == 0) fan = ld_bf16(FB + (size_t)(row + 1) * D, F.lane);
                else { fan = ld_bf16(OP + (size_t)pan * D, F.lane); fbn = ld_bf16(OP + (size_t)pbn * D, F.lane); wa = wan; wb = wbn;
                    if (i + 2 < nr) { pan = min(max(tp[2 * row + 4], 0), MOE_MAXT * 256 - 1); pbn = min(max(tp[2 * row + 5], 0), MOE_MAXT * 256 - 1); wan = tw[2 * row + 4]; wbn = tw[2 * row + 5]; } }
                xn = xf ? ld_f32(xp0 + (size_t)(i + 1) * D, F.lane) : ld_bf16nt(xb0 + (size_t)(i + 1) * D, F.lane); }
            const float rf = row_rinv(f);
            float* xp = xp0 + (size_t)i * D;
#pragma unroll
            for (int j = 0; j < 4; ++j) x.v[j] = x.v[j] + gt2.v[j] * (f.v[j] * rf * gpo.v[j]);
            if (xf || l == 1) st_f32(xp, F.lane, x); else st_bf16nt((bf16*)F.out + (size_t)row * D, F.lane, x);
            if (l == 0) { const float r3 = row_rinv(x);
#pragma unroll
                for (int j = 0; j < 4; ++j) x.v[j] = (x.v[j] * r3 * gn.v[j]) * (1.0f + scn.v[j]) + shn.v[j];
                st_q8(H8 + (size_t)row * D, SR + row, F.lane, x); }
        }
    }
}

__device__ __forceinline__ void moe_gather(Frame& F) {
    const int gw = F.vcu * NWAVES + F.wave, NGW = F.G * NWAVES; const int ntiles = ((const int*)(F.ws + WS_MOE + MOE_META))[0];
    const int* rtok = (const int*)(F.ws + WS_MOE + MOE_ROWTOK); const signed char* H8 = (const signed char*)(F.ws + WS_H); signed char* AS = (signed char*)(F.ws + WS_ASORT);
    const float* SR = (const float*)(F.ws + WS_SROW); float* SS = (float*)(F.ws + WS_SSORT);
    const int np = min(max(ntiles, 0), MOE_MAXT) * 256;
    for (int pos = gw; pos < np; pos += 4 * NGW) {
        int tok[4]; u32x4 a[4]; float sc[4];
#pragma unroll
        for (int q = 0; q < 4; ++q) { const int p = pos + q * NGW; tok[q] = p < np ? min(max(rtok[p], 0), TL - 1) : 0; }
#pragma unroll
        for (int q = 0; q < 4; ++q) { a[q] = *(const u32x4*)(H8 + (size_t)tok[q] * D + 16 * F.lane); sc[q] = SR[tok[q]]; }
#pragma unroll
        for (int q = 0; q < 4; ++q) { const int p = pos + q * NGW; if (p < np) { *(u32x4*)(AS + (size_t)p * D + 16 * F.lane) = a[q]; if (F.lane == 0) SS[p] = sc[q]; } } }
}

constexpr int GP = 144;
constexpr int G_VS = 0, G_QT = 9216, G_QH = 18432, G_KT = 27648, G_KH = 36864, G_AM = 46080, G_B = 55296, G_LR = 71680, G_TOT = 75776, G_ROPE = 77824, G_OB = 86016;
__device__ __forceinline__ bf16x8 cat8(s16x4 a, s16x4 b) { return __builtin_shufflevector(a, b, 0, 1, 2, 3, 4, 5, 6, 7); }
__device__ __forceinline__ bf16x8 pack8(f32x4 a, f32x4 b) { u32x4 p; p.x = pk2(a[0], a[1]); p.y = pk2(a[2], a[3]); p.z = pk2(b[0], b[1]); p.w = pk2(b[2], b[3]); return __builtin_bit_cast(bf16x8, p); }
__device__ __forceinline__ void gla_phase(Frame& F, int layer) {
    const bf16* proj = (const bf16*)(F.ws + WS_BIG); bf16* Obuf = (bf16*)(F.ws + WS_O); const float* rope = (const float*)(F.ws + WS_ROPE);
    LAS unsigned char* L = F.lds;
    const int t = F.tid, lane = F.lane, w = F.wave, g = lane >> 4, l15 = lane & 15, r4 = l15 >> 2, c4 = l15 & 3;
    LAS float* LB = (LAS float*)(L + G_B); LAS float* TOT = (LAS float*)(L + G_TOT);
    for (int u = F.vcu; u < 256; u += F.G) {
        const int b = u >> 4, h = (u >> 2) & 3, dir = (u >> 1) & 1, vh = u & 1;
        const int gtd = w & 3, gtsh = w >> 2;
        bf16x8 wgf;
        { const float* WG = F.inp(I_GWG) + ((size_t)(layer * 2 + dir) * 16 + 8 * (g & 1)) * 256 + 64 * h + 16 * gtd + l15;
          float wv[8];
#pragma unroll
          for (int j = 0; j < 8; ++j) wv[j] = g < 2 ? WG[j * 256] : 0.f;
          u32x4 pk; pk.x = pk2(wv[0], wv[1]); pk.y = pk2(wv[2], wv[3]); pk.z = pk2(wv[4], wv[5]); pk.w = pk2(wv[6], wv[7]); wgf = __builtin_bit_cast(bf16x8, pk); }
        const float bg = F.inp(I_GBG)[(layer * 2 + dir) * 256 + 64 * h + 16 * gtd + l15];
        bf16x8 cumA0, cumA1;
        { unsigned m[4];
#pragma unroll
          for (int j = 0; j < 4; ++j) m[j] = (4 * g + j <= l15) ? 0x3F80u : 0u;
          const u32x4 a0 = {m[0] | (m[1] << 16), m[2] | (m[3] << 16), 0u, 0u}, a1 = {0x3F803F80u, 0x3F803F80u, m[0] | (m[1] << 16), m[2] | (m[3] << 16)};
          cumA0 = __builtin_bit_cast(bf16x8, a0); cumA1 = __builtin_bit_cast(bf16x8, a1); }
        f32x4 S[4];
#pragma unroll
        for (int i = 0; i < 4; ++i) S[i] = (f32x4){0.f, 0.f, 0.f, 0.f};
        const int tensor = t >> 8, s = (t & 255) >> 2, p = t & 3, d0 = (p & 1) * 8 + (p >> 1) * 32;
        const int spos = dir ? 63 - s : s;
        const int sv = t >> 3, c8 = t & 7, svpos = dir ? 63 - sv : sv;
        const int sl = (t & 127) >> 1, hf = t & 1, slpos = dir ? 63 - sl : sl;
#define GLA_ROWBASE(ci_) ((ci_) < 4 ? TL + b * 256 + 64 * (dir ? 3 - (ci_) : (ci_)) : b * 4096 + 64 * (dir ? 63 - ((ci_) - 4) : ((ci_) - 4)))
        u32x4 c1n, c2n, vvn, lvn;
        { const int rb0 = GLA_ROWBASE(0); const bf16* src = proj + (size_t)(rb0 + spos) * PP + tensor * 256 + 64 * h + d0; c1n = *(const u32x4*)src; c2n = *(const u32x4*)(src + 16);
          vvn = *(const u32x4*)(proj + (size_t)(rb0 + svpos) * PP + C_GV + 128 * h + 64 * vh + 8 * c8);
          lvn = *(const u32x4*)(proj + (size_t)(rb0 + slpos) * PP + C_LR + 16 * dir + 8 * hf); }
        for (int i = t; i < 2048; i += 512) ((LAS float*)(L + G_ROPE))[i] = rope[i];
        int prev_rowbase = 0;
        for (int ci = 0; ci < 68; ++ci) {
            const int rowbase = GLA_ROWBASE(ci), rope_on = ci >= 4, rowpos = dir ? 63 - (ci - 4) : (ci - 4);
            const u32x4 c1 = c1n, c2 = c2n;
            *(LAS u32x4*)(L + G_VS + sv * GP + c8 * 16) = vvn;
            if (t < 128) *(LAS u32x4*)(L + G_LR + sl * 32 + hf * 16) = lvn;
            if (ci > 0) { const u32x4 ov = *(const LAS u32x4*)(L + G_OB + sv * GP + c8 * 16);
                *(u32x4*)(Obuf + (size_t)dir * TT * 512 + (size_t)(prev_rowbase + svpos) * 512 + 128 * h + 64 * vh + 8 * c8) = ov; }
            prev_rowbase = rowbase;
            if (ci + 1 < 68) { const int rb1 = GLA_ROWBASE(ci + 1); const bf16* src = proj + (size_t)(rb1 + spos) * PP + tensor * 256 + 64 * h + d0; c1n = *(const u32x4*)src; c2n = *(const u32x4*)(src + 16);
              vvn = *(const u32x4*)(proj + (size_t)(rb1 + svpos) * PP + C_GV + 128 * h + 64 * vh + 8 * c8);
              lvn = *(const u32x4*)(proj + (size_t)(rb1 + slpos) * PP + C_LR + 16 * dir + 8 * hf); }
            __syncthreads();
            f32x4 bl[2];
            { f32x4 gt[2];
#pragma unroll
              for (int i = 0; i < 2; ++i) { const bf16x8 af = *(const LAS bf16x8*)(L + G_LR + (16 * (2 * gtsh + i) + l15) * 32 + (g & 1) * 16);
                  f32x4 z = mfma16(af, wgf, (f32x4){0.f, 0.f, 0.f, 0.f});
#pragma unroll
                  for (int r = 0; r < 4; ++r) { const float zz = z[r] + bg; z[r] = (fminf(zz, 0.f) - __logf(1.0f + __expf(-fabsf(zz)))) * (1.0f / 16.0f); }
                  gt[i] = z; }
              const bf16x8 gB = pack8(gt[0], gt[1]);
              bl[0] = mfma16(cumA0, gB, (f32x4){0.f, 0.f, 0.f, 0.f}); bl[1] = mfma16(cumA1, gB, (f32x4){0.f, 0.f, 0.f, 0.f}); }
            if (gtsh == 0 && g == 3) TOT[16 * gtd + l15] = bl[1][3];
            __syncthreads();
            { const float off = gtsh ? TOT[16 * gtd + l15] : 0.f;
#pragma unroll
              for (int i = 0; i < 2; ++i)
#pragma unroll
                  for (int r = 0; r < 4; ++r) LB[(32 * gtsh + 16 * i + 4 * g + r) * 64 + 16 * gtd + l15] = bl[i][r] + off; }
            __syncthreads();
            { float x1[8], x2[8];
              x1[0] = bflo(c1.x); x1[1] = bfhi(c1.x); x1[2] = bflo(c1.y); x1[3] = bfhi(c1.y); x1[4] = bflo(c1.z); x1[5] = bfhi(c1.z); x1[6] = bflo(c1.w); x1[7] = bfhi(c1.w);
              x2[0] = bflo(c2.x); x2[1] = bfhi(c2.x); x2[2] = bflo(c2.y); x2[3] = bfhi(c2.y); x2[4] = bflo(c2.z); x2[5] = bfhi(c2.z); x2[6] = bflo(c2.w); x2[7] = bfhi(c2.w);
              if (rope_on) { const int pos = (p >> 1) ? spos : rowpos; const LAS float* rt = (const LAS float*)(L + G_ROPE) + (pos * 16 + (p & 1) * 8) * 2;
#pragma unroll
                  for (int jj = 0; jj < 8; ++jj) { const float cs = rt[2 * jj], sn = rt[2 * jj + 1]; const float a = x1[jj], bq = x2[jj]; x1[jj] = a * cs - bq * sn; x2[jj] = a * sn + bq * cs; } }
              const LAS float* Bs = LB + s * 64; const LAS float* Bref = LB + 32 * 64;
              float t1[8], t2[8];
              const float sgn = tensor ? -1.0f : 1.0f, sc0 = tensor ? 1.0f : 0.125f;
#pragma unroll
              for (int jj = 0; jj < 8; ++jj) { const float eA = (Bs[d0 + jj] - Bref[d0 + jj]) * sgn, eB = (Bs[d0 + 16 + jj] - Bref[d0 + 16 + jj]) * sgn;
                  t1[jj] = x1[jj] * sc0 * __expf(eA); t2[jj] = x2[jj] * sc0 * __expf(eB); }
              LAS unsigned char* pt = L + (tensor ? G_KT : G_QT) + s * GP + d0 * 2;
              *(LAS u32x4*)pt = (u32x4){pk2(t1[0], t1[1]), pk2(t1[2], t1[3]), pk2(t1[4], t1[5]), pk2(t1[6], t1[7])};
              *(LAS u32x4*)(pt + 32) = (u32x4){pk2(t2[0], t2[1]), pk2(t2[2], t2[3]), pk2(t2[4], t2[5]), pk2(t2[6], t2[7])}; }
            if (t < 192) { const int j = t >> 6, d = t & 63; const float br = LB[32 * 64 + d], bt = LB[63 * 64 + d];
                ((LAS float*)(L + G_QH))[t] = __expf(j == 0 ? br : (j == 1 ? bt - br : bt)); }
            __syncthreads();
#pragma unroll
            for (int i = 0; i < 2; ++i) { const int id = 2 * w + i, ts = id >> 2, tc = id & 3;
                f32x4 a = (f32x4){0.f, 0.f, 0.f, 0.f};
                if (ts <= tc) {
#pragma unroll
                    for (int ks = 0; ks < 2; ++ks) { const bf16x8 kf = *(const LAS bf16x8*)(L + G_KT + (16 * ts + l15) * GP + (8 * g + 32 * ks) * 2);
                        const bf16x8 qf = *(const LAS bf16x8*)(L + G_QT + (16 * tc + l15) * GP + (8 * g + 32 * ks) * 2); a = mfma16(kf, qf, a); } }
                const int c = 16 * tc + l15;
#pragma unroll
                for (int r = 0; r < 4; ++r) a[r] = (16 * ts + 4 * g + r <= c) ? a[r] : 0.f;
                u32x2 wv; wv.x = pk2(a[0], a[1]); wv.y = pk2(a[2], a[3]);
                *(LAS u32x2*)(L + G_AM + c * GP + (16 * ts + 4 * g) * 2) = wv; }
            __syncthreads();
            { const int vt = w & 3, chh = w >> 2; const LAS float* COL = (const LAS float*)(L + G_QH);
              bf16x8 Vf[2], Sb[2];
#pragma unroll
              for (int ks = 0; ks < 2; ++ks) { const LAS unsigned char* pa = L + G_VS + (32 * ks + 8 * g + r4) * GP + (16 * vt + 4 * c4) * 2;
                  Vf[ks] = cat8(tr_read(pa), tr_read(pa + 4 * GP));
                  const f32x4 c0 = *(const LAS f32x4*)(COL + 32 * ks + 4 * g), c1 = *(const LAS f32x4*)(COL + 32 * ks + 16 + 4 * g);
                  Sb[ks] = pack8(S[2 * ks] * c0, S[2 * ks + 1] * c1); }
#pragma unroll
              for (int i = 0; i < 2; ++i) { const int tc = 2 * chh + i, c = 16 * tc + l15;
                  f32x4 o = (f32x4){0.f, 0.f, 0.f, 0.f};
#pragma unroll
                  for (int ks = 0; ks < 2; ++ks) { const u32x2 q0 = *(const LAS u32x2*)(L + G_QT + c * GP + (32 * ks + 4 * g) * 2), q1 = *(const LAS u32x2*)(L + G_QT + c * GP + (32 * ks + 16 + 4 * g) * 2);
                      o = mfma16(__builtin_bit_cast(bf16x8, ((u32x4){q0.x, q0.y, q1.x, q1.y})), Sb[ks], o); }
#pragma unroll
                  for (int ks = 0; ks < 2; ++ks) if (32 * ks <= 16 * tc + 15) { const bf16x8 am = *(const LAS bf16x8*)(L + G_AM + c * GP + (32 * ks + 8 * g) * 2); o = mfma16(am, Vf[ks], o); }
#pragma unroll
                  for (int r = 0; r < 4; ++r) *(LAS bf16*)(L + G_OB + (16 * tc + 4 * g + r) * GP + (16 * vt + l15) * 2) = (bf16)f2bf(o[r]); }
#pragma unroll
              for (int dt = 0; dt < 4; ++dt) { f32x4 T = (f32x4){0.f, 0.f, 0.f, 0.f};
#pragma unroll
                  for (int ks = 0; ks < 2; ++ks) { const LAS unsigned char* pa = L + G_KT + (32 * ks + 8 * g + r4) * GP + (16 * dt + 4 * c4) * 2;
                      T = mfma16(cat8(tr_read(pa), tr_read(pa + 4 * GP)), Vf[ks], T); }
                  const f32x4 ck = *(const LAS f32x4*)(COL + 64 + 16 * dt + 4 * g), dc = *(const LAS f32x4*)(COL + 128 + 16 * dt + 4 * g);
                  S[dt] = S[dt] * dc + T * ck; } }
            __syncthreads();
        }
        { const u32x4 ov = *(const LAS u32x4*)(L + G_OB + sv * GP + c8 * 16);
          *(u32x4*)(Obuf + (size_t)dir * TT * 512 + (size_t)(prev_rowbase + svpos) * 512 + 128 * h + 64 * vh + 8 * c8) = ov; }
        __syncthreads();
#undef GLA_ROWBASE
    }
}
__device__ __forceinline__ void gla_combine(Frame& F, int layer) {
    const int gw = F.vcu * NWAVES + F.wave; const bf16* proj = (const bf16*)(F.ws + WS_BIG); const bf16* Of = (const bf16*)(F.ws + WS_O); const bf16* Ob = Of + (size_t)TT * 512;
    bf16* Hc = (bf16*)(F.ws + WS_H);
    float gn[8];
#pragma unroll
    for (int i = 0; i < 8; ++i) gn[i] = F.inp(I_GGN)[layer * 128 + ((8 * F.lane) & 127) + i];
    const int nseg = layer == 0 ? 2 : 1;
    for (int seg = 0; seg < nseg; ++seg) { const int r0 = seg ? TL + 2 * gw : 32 * gw, nr = seg ? 2 : 32;
        u32x4 an = *(const u32x4*)(Of + (size_t)r0 * 512 + 8 * F.lane), bn = *(const u32x4*)(Ob + (size_t)r0 * 512 + 8 * F.lane), rn = *(const u32x4*)(proj + (size_t)r0 * PP + C_GR + 8 * F.lane);
        for (int i = 0; i < nr; ++i) { const int row = r0 + i;
            const u32x4 a = an, b = bn, r = rn;
            if (i + 1 < nr) { an = *(const u32x4*)(Of + (size_t)(row + 1) * 512 + 8 * F.lane); bn = *(const u32x4*)(Ob + (size_t)(row + 1) * 512 + 8 * F.lane); rn = *(const u32x4*)(proj + (size_t)(row + 1) * PP + C_GR + 8 * F.lane); }
            float o[8], rr[8];
            o[0] = bflo(a.x) + bflo(b.x); o[1] = bfhi(a.x) + bfhi(b.x); o[2] = bflo(a.y) + bflo(b.y); o[3] = bfhi(a.y) + bfhi(b.y); o[4] = bflo(a.z) + bflo(b.z); o[5] = bfhi(a.z) + bfhi(b.z); o[6] = bflo(a.w) + bflo(b.w); o[7] = bfhi(a.w) + bfhi(b.w);
            rr[0] = bflo(r.x); rr[1] = bfhi(r.x); rr[2] = bflo(r.y); rr[3] = bfhi(r.y); rr[4] = bflo(r.z); rr[5] = bfhi(r.z); rr[6] = bflo(r.w); rr[7] = bfhi(r.w);
            float ss = 0.f;
#pragma unroll
            for (int q = 0; q < 8; ++q) ss += o[q] * o[q];
            ss = red_row16<OpAdd>(ss);
            const float ri = 1.0f / sqrtf(ss * (1.0f / 128.0f) + EPS);
            float v[8];
#pragma unroll
            for (int q = 0; q < 8; ++q) v[q] = (o[q] * ri * gn[q]) * (rr[q] / (1.0f + __expf(-rr[q])));
            *(u32x4*)(Hc + (size_t)row * D + 8 * F.lane) = (u32x4){pk2(v[0], v[1]), pk2(v[2], v[3]), pk2(v[4], v[5]), pk2(v[6], v[7])}; } }
}

constexpr int NA_CK = 0, NA_CV = 36864;
constexpr int NA_RK = 0, NA_RV = 63360, NA_RPB = 126720;
constexpr float NA_SC = 0.125f * 1.44269504f;
struct NaSt { float m, l; f32x4 OT[4]; };
__device__ __forceinline__ int na_sw(int row, int c) { return row * 144 + (c << 4); }
__device__ __forceinline__ void na_softmax(NaSt& st, f32x4 (&s)[4], bf16x8 (&pf)[2]) {
    float mx = fmaxf(fmaxf(fmaxf(s[0][0], s[0][1]), fmaxf(s[0][2], s[0][3])), fmaxf(fmaxf(s[1][0], s[1][1]), fmaxf(s[1][2], s[1][3])));
    mx = fmaxf(mx, fmaxf(fmaxf(fmaxf(s[2][0], s[2][1]), fmaxf(s[2][2], s[2][3])), fmaxf(fmaxf(s[3][0], s[3][1]), fmaxf(s[3][2], s[3][3]))));
    mx = red_x32<OpMax>(red_x16<OpMax>(mx));
    const float mnew = fmaxf(st.m, mx), alpha = __builtin_amdgcn_exp2f(st.m - mnew);
    float ps = 0.f;
#pragma unroll
    for (int i = 0; i < 4; ++i)
#pragma unroll
        for (int r = 0; r < 4; ++r) { const float pv = __builtin_amdgcn_exp2f(s[i][r] - mnew); s[i][r] = pv; ps += pv; }
    st.l = st.l * alpha + ps; st.m = mnew;
#pragma unroll
    for (int dt = 0; dt < 4; ++dt) st.OT[dt] *= alpha;
    pf[0] = pack8(s[0], s[1]); pf[1] = pack8(s[2], s[3]);
}
__device__ __forceinline__ void na_ctx_chunks(NaSt& st, const LAS unsigned char* L, int g, int l15, int r4, int c4, const bf16x8 (&qf)[2]) {
#pragma unroll 1
    for (int cc = 0; cc < 4; ++cc) {
        f32x4 s[4]; bf16x8 pf[2];
#pragma unroll
        for (int i = 0; i < 4; ++i) { const int key = 16 * (4 * cc + i) + l15;
            const bf16x8 k0 = *(const LAS bf16x8*)(L + NA_CK + na_sw(key, g)), k1 = *(const LAS bf16x8*)(L + NA_CK + na_sw(key, g + 4));
            f32x4 a = mfma16(k0, qf[0], (f32x4){0.f, 0.f, 0.f, 0.f}); a = mfma16(k1, qf[1], a); s[i] = a * NA_SC; }
        na_softmax(st, s, pf);
#pragma unroll
        for (int kk = 0; kk < 2; ++kk) { const int key = 16 * (4 * cc + 2 * kk) + 4 * g + r4;
#pragma unroll
            for (int dt = 0; dt < 4; ++dt) {
                const LAS unsigned char* pa = L + NA_CV + na_sw(key, 2 * dt + (c4 >> 1)) + (c4 & 1) * 8;
                const LAS unsigned char* pb = L + NA_CV + na_sw(key + 16, 2 * dt + (c4 >> 1)) + (c4 & 1) * 8;
                st.OT[dt] = mfma16(cat8(tr_read(pa), tr_read(pb)), pf[kk], st.OT[dt]); } }
    }
}
__device__ __forceinline__ void na_finish(NaSt& st, bf16* dst  , int g) {
    float l = red_x32<OpAdd>(red_x16<OpAdd>(st.l));
    const float inv = 1.0f / l;
#pragma unroll
    for (int dt = 0; dt < 4; ++dt) { u32x2 wv; wv.x = pk2(st.OT[dt][0] * inv, st.OT[dt][1] * inv); wv.y = pk2(st.OT[dt][2] * inv, st.OT[dt][3] * inv); *(u32x2*)(dst + 16 * dt + 4 * g) = wv; }
}
__device__ __forceinline__ void na_phase(Frame& F, int layer) {
    const bf16* proj = (const bf16*)(F.ws + WS_BIG); bf16* Hc = (bf16*)(F.ws + WS_H);
    LAS unsigned char* L = F.lds; LAS float* RPB = (LAS float*)(L + NA_RPB);
    const int t = F.tid, lane = F.lane, w = F.wave, g = lane >> 4, l15 = lane & 15, r4 = l15 >> 2, c4 = l15 & 3;
    for (int task = F.vcu; task < 256; task += F.G) {
        const int ch = task & 1, h = (task >> 1) & 7, b = task >> 4, kc0 = ch ? 24 : 0;
        const int jb = 2 * ch + (w & 1), c = 16 * jb + l15;
        unsigned* part = (unsigned*)(F.ws + WS_NAPART) + (size_t)task * 128 * 640;
        const bf16* qbase = proj + (size_t)(b * 4096 + c) * PP + C_NQ + 64 * h + 8 * g;
        for (int q = t; q < 4096; q += 512) { const int tensor = q >> 11, key = (q >> 3) & 255, cc8 = q & 7;
            const u32x4 v = *(const u32x4*)(proj + (size_t)(TL + b * 256 + key) * PP + (tensor ? C_NV : C_NK) + 64 * h + 8 * cc8);
            *(LAS u32x4*)(L + (tensor ? NA_CV : NA_CK) + na_sw(key, cc8)) = v; }
        __syncthreads();
        if (layer == 0) {
            const int tok = TL + b * 256 + 128 * ch + 16 * w + l15;
            bf16x8 qf[2];
            { const bf16* qp = proj + (size_t)tok * PP + C_NQ + 64 * h + 8 * g; qf[0] = *(const bf16x8*)qp; qf[1] = *(const bf16x8*)(qp + 32); }
            NaSt st; st.m = -1.0e30f; st.l = 0.f;
#pragma unroll
            for (int dt = 0; dt < 4; ++dt) st.OT[dt] = (f32x4){0.f, 0.f, 0.f, 0.f};
            na_ctx_chunks(st, L, g, l15, r4, c4, qf);
            na_finish(st, Hc + (size_t)tok * D + 512 + 64 * h, g);
        }
        {
            bf16x8 qn[2];
            { const bf16* qp = qbase + (size_t)((w >> 1) * 64) * PP; qn[0] = *(const bf16x8*)qp; qn[1] = *(const bf16x8*)(qp + 32); }
#pragma unroll 1
            for (int i = 0; i < 16; ++i) {
                bf16x8 qf[2]; qf[0] = qn[0]; qf[1] = qn[1];
                if (i + 1 < 16) { const bf16* qp = qbase + (size_t)((4 * (i + 1) + (w >> 1)) * 64) * PP; qn[0] = *(const bf16x8*)qp; qn[1] = *(const bf16x8*)(qp + 32); }
                NaSt st; st.m = -1.0e30f; st.l = 0.f;
#pragma unroll
                for (int dt = 0; dt < 4; ++dt) st.OT[dt] = (f32x4){0.f, 0.f, 0.f, 0.f};
                na_ctx_chunks(st, L, g, l15, r4, c4, qf);
                unsigned* pr = part + (size_t)(8 * i + w) * 640 + lane;
                pr[0] = __builtin_bit_cast(unsigned, st.m); pr[64] = __builtin_bit_cast(unsigned, st.l);
#pragma unroll
                for (int dt = 0; dt < 4; ++dt) { pr[64 * (2 + 2 * dt)] = pk2(st.OT[dt][0], st.OT[dt][1]); pr[64 * (3 + 2 * dt)] = pk2(st.OT[dt][2], st.OT[dt][3]); }
            }
        }
        __syncthreads();
        for (int q = t; q < 8 * 640; q += 512) { const int row = q / 640, rem = q - row * 640, tensor = rem / 320, r2 = rem - tensor * 320, key = r2 >> 3, cc8 = r2 & 7;
            const u32x4 v = *(const u32x4*)(proj + (size_t)(b * 4096 + row * 64 + kc0 + key) * PP + (tensor ? C_NV : C_NK) + 64 * h + 8 * cc8);
            *(LAS u32x4*)(L + (tensor ? NA_RV : NA_RK) + na_sw((row % 11) * 40 + key, cc8)) = v; }
        for (int i = t; i < 465; i += 512) RPB[i] = F.inp(I_RPB)[(size_t)(layer * 8 + h) * 465 + i] * 1.44269504f;
        int have = 7;
        __syncthreads();
        const int kl0 = (jb & 1) ? 8 : 0, lo = kc0 + kl0, cs = min(max(c - 8, 0), 48);
        bf16x8 qn[2]; unsigned pn[10];
        { const bf16* qp = qbase + (size_t)((w >> 1) * 64) * PP; qn[0] = *(const bf16x8*)qp; qn[1] = *(const bf16x8*)(qp + 32);
          const unsigned* pr = part + (size_t)w * 640 + lane;
#pragma unroll
          for (int j = 0; j < 10; ++j) pn[j] = pr[64 * j]; }
#pragma unroll 1
        for (int st_ = 0; st_ < 16; ++st_) {
            const int qrow = 4 * st_ + (w >> 1), tok = b * 4096 + qrow * 64 + c;
            bf16x8 qf[2]; qf[0] = qn[0]; qf[1] = qn[1];
            NaSt st; st.m = __builtin_bit_cast(float, pn[0]); st.l = __builtin_bit_cast(float, pn[1]);
#pragma unroll
            for (int dt = 0; dt < 4; ++dt) st.OT[dt] = (f32x4){bflo(pn[2 + 2 * dt]), bfhi(pn[2 + 2 * dt]), bflo(pn[3 + 2 * dt]), bfhi(pn[3 + 2 * dt])};
            u32x4 pre[5]; int nnew = 0;
            if (st_ + 1 < 16) {
                const int hin = min(max(4 * (st_ + 1) - 1, 0), 56) + 7; nnew = hin - have;
#pragma unroll
                for (int j = 0; j < 5; ++j) { const int q = t + 512 * j;
                    if (q < nnew * 640) { const int ri = q / 640, rem = q - ri * 640, tensor = rem / 320, r2 = rem - tensor * 320, key = r2 >> 3, cc8 = r2 & 7;
                        pre[j] = *(const u32x4*)(proj + (size_t)(b * 4096 + (have + 1 + ri) * 64 + kc0 + key) * PP + (tensor ? C_NV : C_NK) + 64 * h + 8 * cc8); } }
                const bf16* qp = qbase + (size_t)((qrow + 4) * 64) * PP; qn[0] = *(const bf16x8*)qp; qn[1] = *(const bf16x8*)(qp + 32);
                const unsigned* pr = part + (size_t)(8 * (st_ + 1) + w) * 640 + lane;
#pragma unroll
                for (int j = 0; j < 10; ++j) pn[j] = pr[64 * j];
            }
            const int rs = min(max(qrow - 4, 0), 56);
#pragma unroll 1
            for (int lc = 0; lc < 4; ++lc) {
                f32x4 s[4]; bf16x8 pf[2];
#pragma unroll
                for (int kk = 0; kk < 2; ++kk) { const int i = 2 * lc + kk, slot = (rs + i) % 11, roff = rs + i - qrow + 7;
#pragma unroll
                    for (int hf = 0; hf < 2; ++hf) { const int kidx = slot * 40 + kl0 + 16 * hf + l15;
                        const bf16x8 k0 = *(const LAS bf16x8*)(L + NA_RK + na_sw(kidx, g)), k1 = *(const LAS bf16x8*)(L + NA_RK + na_sw(kidx, g + 4));
                        f32x4 a = mfma16(k0, qf[0], (f32x4){0.f, 0.f, 0.f, 0.f}); a = mfma16(k1, qf[1], a);
#pragma unroll
                        for (int r = 0; r < 4; ++r) { const int kc = lo + 16 * hf + 4 * g + r; const bool valid = (kc >= cs) && (kc < cs + 16);
                            const int coff = min(max(kc - c + 15, 0), 30);
                            a[r] = valid ? a[r] * NA_SC + RPB[roff * 31 + coff] : -1.0e30f; }
                        s[2 * kk + hf] = a; } }
                na_softmax(st, s, pf);
#pragma unroll
                for (int kk = 0; kk < 2; ++kk) { const int slot = (rs + 2 * lc + kk) % 11, kidx = slot * 40 + kl0 + 4 * g + r4;
#pragma unroll
                    for (int dt = 0; dt < 4; ++dt) {
                        const LAS unsigned char* pa = L + NA_RV + na_sw(kidx, 2 * dt + (c4 >> 1)) + (c4 & 1) * 8;
                        const LAS unsigned char* pb = L + NA_RV + na_sw(kidx + 16, 2 * dt + (c4 >> 1)) + (c4 & 1) * 8;
                        st.OT[dt] = mfma16(cat8(tr_read(pa), tr_read(pb)), pf[kk], st.OT[dt]); } }
            }
            na_finish(st, Hc + (size_t)tok * D + 512 + 64 * h, g);
            __syncthreads();
            if (nnew > 0) {
#pragma unroll
                for (int j = 0; j < 5; ++j) { const int q = t + 512 * j;
                    if (q < nnew * 640) { const int ri = q / 640, rem = q - ri * 640, tensor = rem / 320, r2 = rem - tensor * 320, key = r2 >> 3, cc8 = r2 & 7;
                        *(LAS u32x4*)(L + (tensor ? NA_RV : NA_RK) + na_sw(((have + 1 + ri) % 11) * 40 + key, cc8)) = pre[j]; } }
                have += nnew;
            }
            __syncthreads();
        }
    }
}


#ifndef REP_P0
#define REP_P0 1
#endif
#ifndef REP_GLA
#define REP_GLA 1
#endif
#ifndef REP_NA
#define REP_NA 1
#endif
#ifndef REP_GEMM
#define REP_GEMM 1
#endif
#ifdef NO_P0
#define PH_P0(x)
#else
#define PH_P0(x) for (int rep_ = 0; rep_ < REP_P0; ++rep_) { x __syncthreads(); }
#endif
#ifdef NO_T
#define PH_T(x)
#else
#define PH_T(x) x
#endif
#ifdef NO_T2
#define PH_T2(x)
#else
#define PH_T2(x) x
#endif
#ifdef NO_GLA
#define PH_GLA(x)
#else
#define PH_GLA(x) for (int rep_ = 0; rep_ < REP_GLA; ++rep_) { x }
#endif
#ifdef NO_NA
#define PH_NA(x)
#else
#define PH_NA(x) for (int rep_ = 0; rep_ < REP_NA; ++rep_) { x }
#endif
#ifdef NO_GEMM
#define PH_GEMM if (0)
#else
#define PH_GEMM _Pragma("unroll 1") for (int rep_ = 0; rep_ < REP_GEMM; ++rep_)
#endif
#define IN(k) (lo <= (k) && (k) < hi)
#define SEAM(k) do { if (IN(k) && IN((k) + 1)) xcd_barrier(bar); } while (0)
template <int L> __device__ __forceinline__ void layer_phases(Frame& F, const XcdBarrier& bar, const int lo, const int hi) {
    constexpr int l = L; constexpr int pb = 2 + 8 * l;
    bf16* Hb = (bf16*)(F.ws + WS_H); bf16* BIG = (bf16*)(F.ws + WS_BIG);
        if (IN(pb + 0)) { pg8::Gemm g{Hb, (const bf16*)(F.ws + WS_WIN + (size_t)l * PP * D), TT, PP, D / 2, nullptr, 0}; pg8::StaticOrder S; S.init(TT, PP, F.G, (int)blockIdx.x);
            pg8::EpiBf16Q E{BIG, PP, (const float*)(F.ws + WS_SROW), (const float*)(F.ws + WS_SB_IN) + (size_t)l * PP, nullptr, 0, 0.f};
            PH_GEMM pg8::gemm_phase<pg8::EpiBf16Q, pg8::StaticOrder, true, false, 1>(F.lds + RING_OFF, g, S, E); }
        SEAM(pb + 0);
        if (IN(pb + 1)) { PH_GLA(gla_phase(F, l);) }
        SEAM(pb + 1);
        if (IN(pb + 2)) { PH_T(gla_combine(F, l);) PH_NA(na_phase(F, l);) }
        SEAM(pb + 2);
        if (IN(pb + 3)) { const int M = l == 0 ? TT : TL; pg8::Gemm g{Hb, (const bf16*)(F.ws + WS_WOUT) + (size_t)l * D * D, M, D, D, nullptr, 0}; pg8::StaticOrder S; S.init(M, D, F.G, (int)blockIdx.x);
            pg8::EpiBf16 E{BIG, D};
            PH_GEMM pg8::gemm_phase<pg8::EpiBf16, pg8::StaticOrder, true, false>(F.lds + RING_OFF, g, S, E); }
        SEAM(pb + 3);
        if (IN(pb + 4)) { PH_T2(t2_postmix(F, l);) }
        SEAM(pb + 4);
        if constexpr (l == 0) {
            if (IN(7)) { pg8::Gemm g{Hb, (const bf16*)(F.ws + WS_WGU0), TT, 2 * DFF, D / 2, nullptr, 0}; pg8::StaticOrder S; S.init(TT, 2 * DFF, F.G, (int)blockIdx.x);
                pg8::EpiSwiGLUQ8 E{(signed char*)BIG, DFF, (const float*)(F.ws + WS_SROW), (const float*)(F.ws + WS_SB_GU0), nullptr, 0, 127.0f / HID_RANGE};
                PH_GEMM pg8::gemm_phase<pg8::EpiSwiGLUQ8, pg8::StaticOrder, true, false, 1>(F.lds + RING_OFF, g, S, E); }
            SEAM(7);
            if (IN(8)) { pg8::Gemm g{BIG, (const bf16*)(F.ws + WS_WD0), TT, D, DFF / 2, nullptr, 0}; pg8::StaticOrder S; S.init(TT, D, F.G, (int)blockIdx.x);
                pg8::EpiBf16Q E{(bf16*)(F.ws + WS_O), D, nullptr, (const float*)(F.ws + WS_SB_D0), nullptr, 0, HID_RANGE / 127.0f};
                PH_GEMM pg8::gemm_phase<pg8::EpiBf16Q, pg8::StaticOrder, true, false, 1>(F.lds + RING_OFF, g, S, E); }
            SEAM(8);
            if (IN(9)) { PH_T(t3_postffn(F, 0);) }
            SEAM(9);
        }
    }
struct Args { const float* in[23]; float* out; unsigned char* ws; int ph_lo, ph_hi, li, pad; };
constexpr int NPHASE = 24;
__global__ void __launch_bounds__(NWAVES * 64, 2) fwd_kernel(Args args) {
    extern __shared__ __attribute__((aligned(16))) unsigned char lds[];
    Frame F;
    F.lds = (LAS unsigned char*)lds;
    F.tid = threadIdx.x; F.lane = F.tid & 63; F.wave = __builtin_amdgcn_readfirstlane(F.tid >> 6);
    F.G = gridDim.x; { const int bx = blockIdx.x; F.vcu = (F.G % 8 == 0) ? (bx % 8) * (F.G / 8) + bx / 8 : bx; }
    F.ws = args.ws; F.out = args.out;
    volatile LAS unsigned* MISC = (volatile LAS unsigned*)(F.lds + MISC_OFF);
    for (int u = F.tid; u < (LDS_BYTES - LDSCTL_OFF) / 4; u += NWAVES * 64) ((LAS unsigned*)(F.lds + LDSCTL_OFF))[u] = 0u;
    if (F.tid < 23) ((LAS unsigned long long*)(F.lds + PTAB_OFF))[F.tid] = (unsigned long long)args.in[F.tid];
    __syncthreads();
    unsigned* ctl = (unsigned*)(F.ws + WS_CTL);
    XcdBarrier bar = xcd_barrier_post(ctl + CW_BAR + args.li * XCD_BAR_WORDS, MISC + 8);
    const int lo = args.ph_lo, hi = args.ph_hi;

    if (IN(0)) { PH_P0(p0_prologue(F);) } SEAM(0);
    if (IN(1)) { PH_T(t1_prenorm(F);) } SEAM(1);

    layer_phases<0>(F, bar, lo, hi);
    layer_phases<1>(F, bar, lo, hi);
    if (IN(15)) { PH_T(m2_lists_gather(F);) }
    SEAM(16);
    for (int sl = 0; sl < MOE_NSL; ++sl) {
        const int pg = 17 + 2 * sl;
        if (IN(pg) || IN(pg + 1)) {
            const int ntiles = min(max(((const int*)(F.ws + WS_MOE + MOE_META))[0], 0), MOE_MAXT);
            const int t0 = sl * MOE_SLT, nts = min(max(ntiles - t0, 0), MOE_SLT);
            LAS int* texp = (LAS int*)(F.lds + IDX_OFF);
            if (nts > 0) { if (F.tid < MOE_SLT) texp[F.tid] = min(max(((const int*)(F.ws + WS_MOE + MOE_TEXP))[t0 + F.tid], 0), NE - 1); __syncthreads(); }
            if (IN(pg) && nts > 0) {
                pg8::StaticOrder S; S.init(nts * 256, 2 * DFE, F.G, (int)blockIdx.x);
                pg8::Gemm g{(const bf16*)(F.ws + WS_ASORT + (size_t)t0 * 256 * D), (const bf16*)(F.ws + WS_WGU1), nts * 256, 2 * DFE, D / 2, texp, (size_t)DFE * D};
                pg8::EpiSwiGLUQ8 E{(signed char*)(F.ws + WS_HIDS), DFE, (const float*)(F.ws + WS_SSORT) + (size_t)t0 * 256, (const float*)(F.ws + WS_SB_GU1), texp, 2 * DFE, 127.0f / HID_RANGE};
                PH_GEMM pg8::gemm_phase<pg8::EpiSwiGLUQ8, pg8::StaticOrder, true, true, 1>(F.lds + RING_OFF, g, S, E);
            }
            SEAM(pg);
            if (IN(pg + 1) && nts > 0) {
                pg8::StaticOrder S; S.init(nts * 256, D, F.G, (int)blockIdx.x);
                pg8::Gemm g{(const bf16*)(F.ws + WS_HIDS), (const bf16*)(F.ws + WS_WD1), nts * 256, D, DFE / 2, texp, (size_t)D * DFE / 2};
                pg8::EpiBf16Q E{(bf16*)(F.ws + WS_OUTP) + (size_t)t0 * 256 * D, D, nullptr, (const float*)(F.ws + WS_SB_D1), texp, D, HID_RANGE / 127.0f};
                PH_GEMM pg8::gemm_phase<pg8::EpiBf16Q, pg8::StaticOrder, true, true, 1>(F.lds + RING_OFF, g, S, E);
            }
            SEAM(pg + 1);
        } else { SEAM(pg); SEAM(pg + 1); }
    }
    if (IN(17 + 2 * MOE_NSL)) { PH_T(t3_postffn(F, 1);) }
}

#ifndef MK_LAUNCH_PER_PHASE
#define MK_LAUNCH_PER_PHASE 0
#endif
extern "C" void kernel_launch(void* const* d_in, const int* in_sizes, int n_in, void* d_out, int out_size, void* d_ws, size_t ws_size, hipStream_t stream) {
    static int grid = 0;
    if (grid == 0) {
        if (n_in != 23 || out_size != TL * D || ws_size < WS_END) { fprintf(stderr, "kernel_launch: unexpected shapes (n_in %d, out %d, ws %zu)\n", n_in, out_size, ws_size); grid = -1; return; }
        int dev = 0, cus = 0, per_cu = 0;
        if (hipGetDevice(&dev) != hipSuccess || hipDeviceGetAttribute(&cus, hipDeviceAttributeMultiprocessorCount, dev) != hipSuccess) { grid = -1; return; }
        if (hipFuncSetAttribute((const void*)fwd_kernel, hipFuncAttributeMaxDynamicSharedMemorySize, LDS_BYTES) != hipSuccess) { fprintf(stderr, "kernel_launch: hipFuncSetAttribute failed\n"); grid = -1; return; }
        if (hipOccupancyMaxActiveBlocksPerMultiprocessor(&per_cu, (const void*)fwd_kernel, NWAVES * 64, LDS_BYTES) != hipSuccess || per_cu < 1) fprintf(stderr, "kernel_launch: occupancy query reports %d\n", per_cu);
        (void)hipGetLastError();
        grid = 256;
        if (cus < 256) fprintf(stderr, "kernel_launch: device has %d CUs, this kernel needs 256\n", cus);
    }
    if (grid < 0) return;
    if (hipMemsetAsync((char*)d_ws + WS_CTL, 0, CTL_ZERO_BYTES, stream) != hipSuccess) return;
    Args a{};
    for (int i = 0; i < 23; ++i) a.in[i] = (const float*)d_in[i];
    a.out = (float*)d_out; a.ws = (unsigned char*)d_ws;
#if MK_LAUNCH_PER_PHASE
    for (int p = 0; p < NPHASE; ++p) { a.ph_lo = p; a.ph_hi = p + 1; a.li = 0; a.pad = 0;
        hipLaunchKernelGGL(fwd_kernel, dim3(grid), dim3(NWAVES * 64), LDS_BYTES, stream, a); }
#else
    a.ph_lo = 0; a.ph_hi = NPHASE; a.li = 0; a.pad = 0;
    hipLaunchKernelGGL(fwd_kernel, dim3(grid), dim3(NWAVES * 64), LDS_BYTES, stream, a);
#endif
}
```
